# Optimizing an MI355X kernel written in HIP

```python
import jax, jax.numpy as jnp
from jax import lax
import numpy as np

D_MODEL = 2048
BATCH = 4
SEQ = 4096
DEPTH = 1
DEC_BATCH = 8
DEC_SEQ = 16
PAST_LEN = 4096

CHUNK = 64
N_META = 16
CONV_WIDTH = 1024
SHORTCONV_K = 3
N_GDN_HEADS = 8
GDN_DK = 128
GDN_DV = 128
GDN_QK = N_GDN_HEADS * GDN_DK
GDN_V = N_GDN_HEADS * GDN_DV
GDN_CONV_K = 4
QKV_WIDTH = 2 * GDN_QK + GDN_V
MIX_WIDTH = CONV_WIDTH + GDN_V
D_FF = 5632
FFN_CONV_K = 3
EPS = 1e-6
SPLITS = list(np.cumsum([CONV_WIDTH, CONV_WIDTH, CONV_WIDTH, QKV_WIDTH, GDN_V, N_GDN_HEADS]))
IN_COLS = 3 * CONV_WIDTH + QKV_WIDTH + GDN_V + 2 * N_GDN_HEADS

kernel_name = "hymba_conv_gdn_streaming_step"


def rms_norm(x, g):
    xf = x.astype(jnp.float32)
    y = xf * lax.rsqrt(jnp.mean(xf * xf, -1, keepdims=True) + EPS)
    return y * g.astype(jnp.float32)


def l2norm(x):
    return x * lax.rsqrt(jnp.sum(x * x, -1, keepdims=True) + EPS)


def causal_dwconv(x, hist, w):
    K = w.shape[0]
    T = x.shape[1]
    xp = jnp.concatenate([hist.astype(x.dtype), x], axis=1)
    y = sum(xp[:, j:j + T] * w[j] for j in range(K))
    return y, xp[:, -(K - 1):]


def gated_delta_chunked(q, k, v, g, beta, S0):
    Bn, T, H, dk = q.shape
    dv = v.shape[-1]
    n = T // CHUNK

    def to_chunks(a):
        return a.reshape(Bn, n, CHUNK, H, *a.shape[3:]).swapaxes(2, 3)

    qc, kc, vc, gc, bc = map(to_chunks, (q, k, v, g, beta))
    gcum = jnp.cumsum(gc, axis=-1)
    idx = jnp.arange(CHUNK)
    lower_incl = idx[:, None] >= idx[None, :]
    strict = idx[:, None] > idx[None, :]
    diff = gcum[..., :, None] - gcum[..., None, :]
    decay_mat = jnp.exp(jnp.where(lower_incl, diff, -jnp.inf))
    kb = kc * bc[..., None]
    M = jnp.einsum('bnhid,bnhjd->bnhij', kb, kc) * jnp.where(strict, decay_mat, 0.0)
    A = jnp.eye(CHUNK, dtype=jnp.float32) + M
    rhs = jnp.concatenate([vc * bc[..., None], kb * jnp.exp(gcum)[..., None]], axis=-1)
    sol = lax.linalg.triangular_solve(A, rhs, left_side=True, lower=True, unit_diagonal=True)
    u, w = sol[..., :dv], sol[..., dv:]
    attn_in = jnp.einsum('bnhid,bnhjd->bnhij', qc, kc) * decay_mat

    def step(S, xs):
        qn, kn, un, wn, gn, an = xs
        v_new = un - jnp.einsum('bhld,bhde->bhle', wn, S)
        o = (jnp.einsum('bhld,bhde->bhle', qn * jnp.exp(gn)[..., None], S)
             + jnp.einsum('bhij,bhje->bhie', an, v_new))
        g_last = gn[..., -1:]
        S = (S * jnp.exp(g_last)[..., None]
             + jnp.einsum('bhld,bhle->bhde', kn * jnp.exp(g_last - gn)[..., None], v_new))
        return S, o

    xs = tuple(jnp.moveaxis(a, 1, 0) for a in (qc, kc, u, w, gcum, attn_in))
    S, o = lax.scan(step, S0, xs)
    o = jnp.moveaxis(o, 0, 1).swapaxes(2, 3).reshape(Bn, T, H, dv)
    return o, S


def gdn_run(q, k, v, g, beta, S0, front):
    T = q.shape[1]
    back = (-(T + front)) % CHUNK

    def pad(a):
        return jnp.pad(a, [(0, 0), (front, back)] + [(0, 0)] * (a.ndim - 2))

    o, S = gated_delta_chunked(pad(q), pad(k), pad(v), pad(g), pad(beta), S0)
    return o[:, front:front + T], S


def layer_forward(x, hist_a, hist_qkv, S0, hist_ffn, front,
                  g_pre_mix, w_in, w_conv_a, g_norm_a, w_conv_gdn, a_log, dt_bias,
                  g_norm_gdn, w_out, g_post_mix, g_pre_ffn, w_up, w_conv_ffn, w_down, g_post_ffn):
    Bn, T, _ = x.shape
    dt = x.dtype
    h = rms_norm(x, g_pre_mix).astype(dt)
    proj = h @ w_in
    a_h, a_c, a_b, qkv, z, b_logit, a_logit = jnp.split(proj, SPLITS, axis=-1)
    conv_a, new_hist_a = causal_dwconv(a_c * a_h, hist_a, w_conv_a)
    y_a = rms_norm(a_b * conv_a, g_norm_a)
    qkv_c, new_hist_qkv = causal_dwconv(qkv, hist_qkv, w_conv_gdn)
    qkv_c = jax.nn.silu(qkv_c.astype(jnp.float32))
    q, k, v = jnp.split(qkv_c, [GDN_QK, 2 * GDN_QK], axis=-1)
    q = l2norm(q.reshape(Bn, T, N_GDN_HEADS, GDN_DK)) * (GDN_DK ** -0.5)
    k = l2norm(k.reshape(Bn, T, N_GDN_HEADS, GDN_DK))
    v = v.reshape(Bn, T, N_GDN_HEADS, GDN_DV)
    beta = jax.nn.sigmoid(b_logit.astype(jnp.float32))
    g = -jnp.exp(a_log.astype(jnp.float32)) * jax.nn.softplus(
        a_logit.astype(jnp.float32) + dt_bias.astype(jnp.float32))
    o, S = gdn_run(q, k, v, g, beta, S0.astype(jnp.float32), front)
    zf = z.astype(jnp.float32).reshape(Bn, T, N_GDN_HEADS, GDN_DV)
    y_b = (rms_norm(o, g_norm_gdn) * jax.nn.silu(zf)).reshape(Bn, T, GDN_V)
    mix = jnp.concatenate([y_a, y_b], axis=-1).astype(dt) @ w_out
    x = x + rms_norm(mix, g_post_mix).astype(dt)
    h2 = rms_norm(x, g_pre_ffn).astype(dt)
    up_g, up_v = jnp.split(h2 @ w_up, [D_FF], axis=-1)
    up_gc, new_hist_ffn = causal_dwconv(up_g, hist_ffn, w_conv_ffn)
    f = (jax.nn.silu(up_gc) * up_v) @ w_down
    x = x + rms_norm(f, g_post_ffn).astype(dt)
    return x, (new_hist_a, new_hist_qkv, S.astype(dt), new_hist_ffn)


def run_stack(x, states, front, weights):
    new = []
    for l in range(DEPTH):
        x, st = layer_forward(x, *states[l], front, *(w[l] for w in weights))
        new.append(st)
    stacked = tuple(jnp.stack([s[i] for s in new]) for i in range(4))
    return x, stacked


def setup_inputs(seed: int = 0) -> dict:
    key = jax.random.key(seed)
    ks = jax.random.split(key, 24)
    f32 = jnp.float32
    nrm = lambda k, s, sc: jax.random.normal(k, s, f32) * sc
    gain = lambda k, n: 1.0 + 0.05 * jax.random.normal(k, (DEPTH, n), f32)
    dt0 = jnp.exp(jax.random.uniform(ks[20], (DEPTH, N_GDN_HEADS), f32, np.log(1e-3), np.log(1e-1)))
    return {
        "x_prompt": nrm(ks[0], (BATCH, SEQ, D_MODEL), 1.0),
        "x_sample": nrm(ks[1], (DEC_BATCH, DEC_SEQ, D_MODEL), 1.0),
        "state_conv_a": nrm(ks[2], (DEPTH, DEC_BATCH, SHORTCONV_K - 1, CONV_WIDTH), 1.0),
        "state_gdn_conv": nrm(ks[3], (DEPTH, DEC_BATCH, GDN_CONV_K - 1, QKV_WIDTH), 1.0),
        "state_gdn": nrm(ks[4], (DEPTH, DEC_BATCH, N_GDN_HEADS, GDN_DK, GDN_DV), GDN_DK ** -0.5),
        "state_ffn_conv": nrm(ks[5], (DEPTH, DEC_BATCH, FFN_CONV_K - 1, D_FF), 1.0),
        "meta_tokens": nrm(ks[6], (N_META, D_MODEL), 1.0),
        "g_pre_mix": gain(ks[7], D_MODEL),
        "w_in": nrm(ks[8], (DEPTH, D_MODEL, IN_COLS), D_MODEL ** -0.5),
        "w_conv_a": nrm(ks[9], (DEPTH, SHORTCONV_K, CONV_WIDTH), SHORTCONV_K ** -0.5),
        "g_norm_a": gain(ks[10], CONV_WIDTH),
        "w_conv_gdn": nrm(ks[11], (DEPTH, GDN_CONV_K, QKV_WIDTH), GDN_CONV_K ** -0.5),
        "a_log": jnp.log(jax.random.uniform(ks[12], (DEPTH, N_GDN_HEADS), f32, 1.0, 16.0)),
        "dt_bias": jnp.log(jnp.expm1(dt0)),
        "g_norm_gdn": gain(ks[13], GDN_DV),
        "w_out": nrm(ks[14], (DEPTH, MIX_WIDTH, D_MODEL), MIX_WIDTH ** -0.5),
        "g_post_mix": gain(ks[15], D_MODEL),
        "g_pre_ffn": gain(ks[16], D_MODEL),
        "w_up": nrm(ks[17], (DEPTH, D_MODEL, 2 * D_FF), D_MODEL ** -0.5),
        "w_conv_ffn": nrm(ks[18], (DEPTH, FFN_CONV_K, D_FF), FFN_CONV_K ** -0.5),
        "w_down": nrm(ks[19], (DEPTH, D_FF, D_MODEL), D_FF ** -0.5),
        "g_post_ffn": gain(ks[21], D_MODEL),
    }


def reference(x_prompt, x_sample, state_conv_a, state_gdn_conv, state_gdn, state_ffn_conv,
              meta_tokens, g_pre_mix, w_in, w_conv_a, g_norm_a, w_conv_gdn, a_log, dt_bias,
              g_norm_gdn, w_out, g_post_mix, g_pre_ffn, w_up, w_conv_ffn, w_down, g_post_ffn):
    weights = (g_pre_mix, w_in, w_conv_a, g_norm_a, w_conv_gdn, a_log, dt_bias, g_norm_gdn,
               w_out, g_post_mix, g_pre_ffn, w_up, w_conv_ffn, w_down, g_post_ffn)
    dt = x_prompt.dtype
    meta = jnp.broadcast_to(meta_tokens.astype(dt)[None], (BATCH, N_META, D_MODEL))
    xp = jnp.concatenate([meta, x_prompt], axis=1)
    zero_states = [(jnp.zeros((BATCH, SHORTCONV_K - 1, CONV_WIDTH), dt),
                    jnp.zeros((BATCH, GDN_CONV_K - 1, QKV_WIDTH), dt),
                    jnp.zeros((BATCH, N_GDN_HEADS, GDN_DK, GDN_DV), jnp.float32),
                    jnp.zeros((BATCH, FFN_CONV_K - 1, D_FF), dt)) for _ in range(DEPTH)]
    yp, (nca_p, ngc_p, ngd_p, nfc_p) = run_stack(xp, zero_states, CHUNK - N_META, weights)
    y_prompt = yp[:, N_META:]
    samp_states = [(state_conv_a[l], state_gdn_conv[l], state_gdn[l], state_ffn_conv[l])
                   for l in range(DEPTH)]
    y_sample, (nca_s, ngc_s, ngd_s, nfc_s) = run_stack(x_sample, samp_states, 0, weights)
    return (y_prompt, y_sample, nca_p, ngc_p, ngd_p, nfc_p, nca_s, ngc_s, ngd_s, nfc_s)
```

```cpp
#include <hip/hip_runtime.h>
#include <hip/hip_cooperative_groups.h>
#include <cstdio>
#include <cstdint>
namespace cg = cooperative_groups;

#define LAS __attribute__((address_space(3)))
typedef unsigned short bf16_t;
typedef short bf16x8 __attribute__((ext_vector_type(8)));
typedef float f32x4 __attribute__((ext_vector_type(4)));
typedef unsigned u32x4 __attribute__((ext_vector_type(4)));
typedef unsigned u32x2 __attribute__((ext_vector_type(2)));

constexpr int DM = 2048, NPT = 4112  , ROWS_P = 4 * NPT  , ROWS_V = ROWS_P + 128  , T_PAD = 16640;
constexpr int DFF = 5632, INC = 7184;
constexpr int NITEM_P = 4 * 8 * 65, NITEM = NITEM_P + 64;
constexpr float EPS = 1e-6f;
constexpr size_t O_YP = 0, O_YS = 33554432, O_NCA_P = 33816576, O_NGC_P = 33824768, O_NGD_P = 33861632, O_NFC_P = 34385920,
                 O_NCA_S = 34430976, O_NGC_S = 34447360, O_NGD_S = 34521088, O_NFC_S = 35569664, O_END = 35659776;
constexpr size_t MiB = 1u << 20;
constexpr size_t WS_PART = 1 * MiB;
constexpr size_t WS_EGL = 3 * MiB + 512 * 1024;
constexpr size_t WS_WIN = 4 * MiB;
constexpr size_t WS_WDOWN = 4 * MiB;
constexpr size_t WS_WOUT = 33 * MiB;
constexpr size_t WS_B = 41 * MiB;
constexpr size_t WS_C = 107 * MiB;
constexpr size_t WS_Z = 302 * MiB;
constexpr size_t WS_AB = 334 * MiB + 768 * 1024;
constexpr size_t WS_GDN = 336 * MiB;
constexpr size_t WS_X1 = 445 * MiB;
constexpr size_t WS_WUP = 172 * MiB;
constexpr size_t WS_F = 216 * MiB;
constexpr size_t WS_END = 510 * MiB;
constexpr size_t BLOB = 73984;
static_assert(WS_Z + (size_t)T_PAD * 2048 <= WS_AB && WS_AB + (size_t)T_PAD * 64 <= WS_GDN && WS_GDN + (size_t)NITEM * BLOB <= 488 * MiB && WS_PART + (size_t)T_PAD * 128 <= WS_EGL, "ws map");
constexpr int LDS_BYTES = 147456;
#ifndef PHASE_MASK
#define PHASE_MASK 0xFFFF
#endif
#ifndef P2MASK
#define P2MASK 0xFF
#endif
#define P2(n) if constexpr (((P2MASK) >> (n)) & 1)
#ifndef REPEAT_MASK
#define REPEAT_MASK 0
#endif
#ifndef EXTRA_SYNCS
#define EXTRA_SYNCS 0
#endif
#define PH(n) if constexpr (((PHASE_MASK) >> (n)) & 1)

__device__ __forceinline__ unsigned cvt_pk_bf16(float lo, float hi) { unsigned r; asm volatile("v_cvt_pk_bf16_f32 %0, %1, %2" : "=v"(r) : "v"(lo), "v"(hi)); return r; }
__device__ __forceinline__ unsigned short f2bf(float f) { return (unsigned short)(cvt_pk_bf16(f, 0.f) & 0xffffu); }
__device__ __forceinline__ float bf2f(unsigned short b) { return __uint_as_float((unsigned)b << 16); }
__device__ __forceinline__ float bflo(unsigned w) { return __uint_as_float(w << 16); }
__device__ __forceinline__ float bfhi(unsigned w) { return __uint_as_float(w & 0xffff0000u); }
__device__ __forceinline__ float wave_sum(float v) {
#pragma unroll
    for (int o = 1; o < 64; o <<= 1) v += __shfl_xor(v, o);
    return v;
}
__device__ __forceinline__ float silu_f(float x) { return x * __builtin_amdgcn_rcpf(1.f + __expf(-x)); }
__device__ __forceinline__ int perm32(int k) { return ((k >> 2) & 3) * 8 + ((k >> 4) & 1) * 4 + (k & 3); }
#define LDS_WAIT() asm volatile("s_waitcnt lgkmcnt(0)" ::: "memory")

struct Params {
    const float *xp, *xs, *st_conv_a, *st_gdn_conv, *st_gdn, *st_ffn_conv, *meta, *g_pre_mix, *w_in, *w_conv_a, *g_norm_a, *w_conv_gdn,
                *a_log, *dt_bias, *g_norm_gdn, *w_out, *g_post_mix, *g_pre_ffn, *w_up, *w_conv_ffn, *w_down, *g_post_ffn;
    float* out; unsigned char* ws;
};
__device__ __forceinline__ const float* x_row(const Params& p, int R) {
    if (R < 0) return nullptr;
    if (R < ROWS_P) { const int b = R / NPT, t = R - b * NPT; return t < 16 ? p.meta + (size_t)t * DM : p.xp + ((size_t)b * 4096 + (t - 16)) * DM; }
    if (R < ROWS_V) return p.xs + (size_t)(R - ROWS_P) * DM;
    return nullptr;
}

__device__ __forceinline__ int mu_row(int R) {
    if (R < ROWS_P) { const int b = R / NPT, t = R - b * NPT; return t >= 16 ? b * 4096 + (t - 16) : 16512 + b * 16 + t; }
    return 16384 + (R - ROWS_P);
}

namespace pg8 {
constexpr int BM = 256, BK = 64, HALF = 128, HTB = HALF * BK * 2, STAGE_BYTES = 8 * HTB, NXCD = 8, WGM = 8;
__host__ __device__ __forceinline__ int lds_byte(int r, int c) { const int st = (r >> 4) * 2 + (c >> 5), rr = r & 15, cc = c & 31, ob = rr * 64 + cc * 2; return st * 1024 + (ob ^ (((ob >> 9) & 1) << 5)); }
__host__ __device__ __forceinline__ void stage_rc(int b, int& R, int& C) { const int st = b / 1024, sb = b % 1024, swz = sb ^ (((sb >> 9) & 1) << 5); R = (st >> 1) * 16 + swz / 64; C = (st & 1) * 32 + (swz % 64) / 2; }
__host__ __device__ __forceinline__ int permB(int rho) { const int n = rho >> 4, i = rho & 15; return 8 * (i >> 2) + 4 * n + (i & 3); }
struct Unit { int pm, pn; };
struct Gemm { const bf16_t* A; const bf16_t* Bt; int K; size_t a_tstep; };
struct StaticOrder {
    int nM, nN, nwg, G, c;
    __device__ void init(int nM_, int nN_, int G_, int c_) { nM = nM_; nN = nN_; nwg = nM * nN; G = G_; c = c_; }
    __device__ bool next(int i, Unit& u) const {
        const long L = (long)i * G + c; if (L >= nwg) return false;
        int wgid = (int)L; { const int q = nwg / NXCD, r = nwg % NXCD, xcd = wgid % NXCD, off = wgid / NXCD; wgid = (xcd < r ? xcd * (q + 1) : r * (q + 1) + (xcd - r) * q) + off; }
        const int nig = WGM * nN, gid = wgid / nig, fm = gid * WGM, gsz = (nM - fm) < WGM ? (nM - fm) : WGM;
        u.pm = fm + ((wgid % nig) % gsz); u.pn = (wgid % nig) / gsz; return true;
    }
};
struct PanelOrder {
    int c;
    __device__ bool next(int i, Unit& u) const { if (i >= 2) return false; const int x = c & 7, j = c >> 3; u.pm = 32 * i + 4 * x + (j >> 3); u.pn = j & 7; return true; }
};
template <class Epi, class Sched = StaticOrder>
__device__ __forceinline__ void gemm_phase(LAS unsigned char* lds, const Gemm g, const Sched& S, const Epi& E) {
    int tid_ = threadIdx.x; asm volatile("" : "+v"(tid_));
    const int tid = tid_, wid = __builtin_amdgcn_readfirstlane(tid >> 6), lane = tid & 63, wr = wid >> 2, wc = wid & 3, fr = lane & 15, fq = lane >> 4;
    const int K = g.K, nt = K / BK;
    unsigned voffA[2], voffB[2];
#pragma unroll
    for (int i = 0; i < 2; ++i) { int R, C; stage_rc(tid * 16 + i * 8192, R, C); const int Rb = Epi::PERM ? ((R & ~31) + permB(R & 31)) : R;
        voffA[i] = (unsigned)(R * K + C) * 2u; voffB[i] = (unsigned)(Rb * K + C) * 2u; }
    const size_t kstep = (size_t)(BK * 2);
    const size_t hstep = (size_t)HALF * K * 2;
    const size_t tstepB = 2 * hstep, tstepA = g.a_tstep;
    const unsigned ldsw = (unsigned)wid * 1024u;
    const int aoff = lds_byte(wr * 64 + fr, fq * 8), boff = lds_byte(wc * 32 + fr, fq * 8);
#define PG8_SA(b, h) (((b) * 2 + (h)) * HTB)
#define PG8_SB(b, h) ((4 + (b) * 2 + (h)) * HTB)
#define PG8_STAGE(bufoff, gbase, voff) do { _Pragma("unroll") for (int _i = 0; _i < 2; ++_i) \
        __builtin_amdgcn_global_load_lds((const unsigned*)((const char*)(gbase) + (voff)[_i]), (LAS unsigned*)(lds + (bufoff) + ldsw + _i * 8192), 16, 0, 0); } while (0)
#define PG8_LDA(dst, b, h) do { _Pragma("unroll") for (int m = 0; m < 4; ++m) _Pragma("unroll") for (int k = 0; k < 2; ++k) dst[m][k] = *(const LAS bf16x8*)(lds + PG8_SA(b, h) + aoff + m * 2048 + k * 1024); } while (0)
#define PG8_LDB(dst, b, h) do { _Pragma("unroll") for (int n = 0; n < 2; ++n) _Pragma("unroll") for (int k = 0; k < 2; ++k) dst[n][k] = *(const LAS bf16x8*)(lds + PG8_SB(b, h) + boff + n * 2048 + k * 1024); } while (0)
#define PG8_MMA(ai, bj, At, Bt) do { __builtin_amdgcn_s_setprio(1); _Pragma("unroll") for (int m = 0; m < 4; ++m) _Pragma("unroll") for (int n = 0; n < 2; ++n) _Pragma("unroll") for (int k = 0; k < 2; ++k) \
        acc[ai][bj][m][n] = __builtin_amdgcn_mfma_f32_16x16x32_bf16(Bt[n][k], At[m][k], acc[ai][bj][m][n], 0, 0, 0); __builtin_amdgcn_s_setprio(0); } while (0)
#define PG8_WAIT_V(n) asm volatile("s_waitcnt vmcnt(" #n ")" ::: "memory")
#define PG8_WAIT_L(n) asm volatile("s_waitcnt lgkmcnt(" #n ")" ::: "memory")
#define PG8_BAR __builtin_amdgcn_s_barrier()
#define PG8_SCHED __builtin_amdgcn_sched_barrier(0)
    Unit cur, nxt; int ui = 0;
    if (!S.next(0, cur)) return;
    f32x4 acc[2][2][4][2];
#pragma unroll
    for (int a = 0; a < 2; ++a)
#pragma unroll
        for (int b = 0; b < 2; ++b)
#pragma unroll
            for (int m = 0; m < 4; ++m)
#pragma unroll
                for (int n = 0; n < 2; ++n) acc[a][b][m][n] = (f32x4){0.f, 0.f, 0.f, 0.f};
    bf16x8 At[4][2], B0[2][2], B1[2][2];
    const char* cA = (const char*)g.A + (size_t)cur.pm * tstepA; const char* cB = (const char*)g.Bt + (size_t)cur.pn * tstepB;
    PG8_STAGE(PG8_SB(0, 0), cB, voffB); PG8_STAGE(PG8_SB(0, 1), cB + hstep, voffB); PG8_STAGE(PG8_SA(0, 0), cA, voffA); PG8_STAGE(PG8_SA(0, 1), cA + hstep, voffA);
    if (wr == 1) PG8_BAR;
    PG8_WAIT_V(2); PG8_BAR;
    PG8_STAGE(PG8_SB(1, 0), cB + kstep, voffB); PG8_STAGE(PG8_SA(1, 0), cA + kstep, voffA); PG8_STAGE(PG8_SB(1, 1), cB + hstep + kstep, voffB);
    PG8_WAIT_V(6); PG8_BAR;
    for (;;) {
        const bool has_next = S.next(ui + 1, nxt);
        const char* nA = has_next ? (const char*)g.A + (size_t)nxt.pm * tstepA : cA; const char* nB = has_next ? (const char*)g.Bt + (size_t)nxt.pn * tstepB : cB;
        for (int t = 0; t < nt; t += 2) {
            const bool last = (t == nt - 2);
            const char* a1 = cA + (size_t)(t + 1) * kstep;
            const char* a2 = last ? nA : cA + (size_t)(t + 2) * kstep; const char* b2 = last ? nB : cB + (size_t)(t + 2) * kstep;
            const char* a3 = a2 + kstep; const char* b3 = b2 + kstep;
            PG8_LDB(B0, 0, 0); PG8_LDB(B1, 0, 1); PG8_SCHED; PG8_LDA(At, 0, 0); PG8_STAGE(PG8_SA(1, 1), a1 + hstep, voffA);
            PG8_WAIT_V(8); PG8_WAIT_L(0); PG8_BAR; PG8_MMA(0, 0, At, B0); PG8_MMA(0, 1, At, B1); PG8_BAR; PG8_SCHED;
            PG8_LDA(At, 0, 1); PG8_STAGE(PG8_SB(0, 0), b2, voffB); PG8_STAGE(PG8_SB(0, 1), b2 + hstep, voffB); PG8_STAGE(PG8_SA(0, 0), a2, voffA);
            PG8_WAIT_V(8); PG8_WAIT_L(0); PG8_BAR; PG8_MMA(1, 0, At, B0); PG8_MMA(1, 1, At, B1); PG8_BAR; PG8_SCHED;
            PG8_LDB(B0, 1, 0); PG8_LDB(B1, 1, 1); PG8_SCHED; PG8_LDA(At, 1, 0); PG8_STAGE(PG8_SA(0, 1), a2 + hstep, voffA);
            PG8_WAIT_V(8); PG8_WAIT_L(0); PG8_BAR; PG8_MMA(0, 0, At, B0); PG8_MMA(0, 1, At, B1); PG8_BAR; PG8_SCHED;
            PG8_LDA(At, 1, 1); PG8_STAGE(PG8_SB(1, 0), b3, voffB); PG8_STAGE(PG8_SB(1, 1), b3 + hstep, voffB); PG8_STAGE(PG8_SA(1, 0), a3, voffA);
            PG8_WAIT_V(8); PG8_WAIT_L(0); PG8_BAR; PG8_MMA(1, 0, At, B0); PG8_MMA(1, 1, At, B1); PG8_BAR; PG8_SCHED;
        }
        if (wr == 0) PG8_BAR;
        E(acc, cur, wr, wc, fr, fq);
        if (!has_next) break;
#pragma unroll
        for (int a = 0; a < 2; ++a)
#pragma unroll
            for (int b = 0; b < 2; ++b)
#pragma unroll
                for (int m = 0; m < 4; ++m)
#pragma unroll
                    for (int n = 0; n < 2; ++n) acc[a][b][m][n] = (f32x4){0.f, 0.f, 0.f, 0.f};
        cur = nxt; cA = nA; cB = nB; ++ui;
        if (wr == 1) PG8_BAR;
    }
    PG8_WAIT_V(0);
    PG8_BAR;
#undef PG8_SA
#undef PG8_SB
#undef PG8_STAGE
#undef PG8_LDA
#undef PG8_LDB
#undef PG8_MMA
#undef PG8_WAIT_V
#undef PG8_WAIT_L
#undef PG8_BAR
#undef PG8_SCHED
}

struct EpiProj {
    static constexpr bool PERM = true;
    bf16_t* proj; bf16_t* z; float* ab;
    __device__ __forceinline__ void operator()(const f32x4 (&acc)[2][2][4][2], const Unit& u, int wr, int wc, int fr, int fq) const {
        const int row0 = u.pm * BM + wr * 64 + fr;
        if (u.pn < 28) {
            bf16_t* base; int ldc;
            if (u.pn < 24) { base = proj + u.pn * 256 + wc * 32 + 8 * fq; ldc = 6144; } else { base = z + (u.pn - 24) * 256 + wc * 32 + 8 * fq; ldc = 1024; }
#pragma unroll
            for (int ai = 0; ai < 2; ++ai)
#pragma unroll
                for (int m = 0; m < 4; ++m) { bf16_t* rowp = base + (size_t)(row0 + ai * HALF + m * 16) * ldc;
#pragma unroll
                    for (int bj = 0; bj < 2; ++bj) { const f32x4 v0 = acc[ai][bj][m][0], v1 = acc[ai][bj][m][1];
                        u32x4 w; w.x = cvt_pk_bf16(v0[0], v0[1]); w.y = cvt_pk_bf16(v0[2], v0[3]); w.z = cvt_pk_bf16(v1[0], v1[1]); w.w = cvt_pk_bf16(v1[2], v1[3]);
                        *(u32x4*)(rowp + bj * HALF) = w; } }
        } else if (wc == 0 && fq < 2) {
#pragma unroll
            for (int ai = 0; ai < 2; ++ai)
#pragma unroll
                for (int m = 0; m < 4; ++m) { float* rowp = ab + (size_t)(row0 + ai * HALF + m * 16) * 16 + 8 * fq;
                    *(f32x4*)(rowp) = acc[ai][0][m][0]; *(f32x4*)(rowp + 4) = acc[ai][0][m][1]; }
        }
    }
};
struct EpiBf16Part {
    static constexpr bool PERM = false;
    bf16_t* outb; float* part;
    __device__ __forceinline__ void operator()(const f32x4 (&acc)[2][2][4][2], const Unit& u, int wr, int wc, int fr, int fq) const {
#pragma unroll
        for (int ai = 0; ai < 2; ++ai)
#pragma unroll
            for (int m = 0; m < 4; ++m) {
                const int r = u.pm * BM + ai * HALF + wr * 64 + m * 16 + fr;
                bf16_t* rowp = outb + (size_t)r * DM + u.pn * BM + wc * 32 + 4 * fq;
                float ss = 0.f;
#pragma unroll
                for (int bj = 0; bj < 2; ++bj)
#pragma unroll
                    for (int n = 0; n < 2; ++n) { const f32x4 v = acc[ai][bj][m][n]; ss += (v[0] * v[0] + v[1] * v[1]) + (v[2] * v[2] + v[3] * v[3]);
                        u32x2 w; w.x = cvt_pk_bf16(v[0], v[1]); w.y = cvt_pk_bf16(v[2], v[3]); *(u32x2*)(rowp + bj * HALF + n * 16) = w; }
                ss += __shfl_xor(ss, 16); ss += __shfl_xor(ss, 32);
                if (fq == 0) part[(size_t)r * 32 + u.pn * 4 + wc] = ss;
            }
    }
};
struct EpiFinal {
    static constexpr bool PERM = false;
    float* yout; const bf16_t* x1; const float* g; float* xbuf; unsigned* cnt; LAS float* ex;
    __device__ __forceinline__ void operator()(const f32x4 (&acc)[2][2][4][2], const Unit& u, int wr, int wc, int fr, int fq) const {
        const int tid = threadIdx.x;
        LAS float* P = ex; LAS float* RN = ex + 1024; LAS unsigned* flag = (LAS unsigned*)(ex + 1280);
#pragma unroll
        for (int ai = 0; ai < 2; ++ai)
#pragma unroll
            for (int m = 0; m < 4; ++m) { float ss = 0.f;
#pragma unroll
                for (int bj = 0; bj < 2; ++bj)
#pragma unroll
                    for (int n = 0; n < 2; ++n) { const f32x4 v = acc[ai][bj][m][n]; ss += (v[0] * v[0] + v[1] * v[1]) + (v[2] * v[2] + v[3] * v[3]); }
                ss += __shfl_xor(ss, 16); ss += __shfl_xor(ss, 32);
                if (fq == 0) P[(ai * HALF + wr * 64 + m * 16 + fr) * 4 + wc] = ss; }
        asm volatile("s_waitcnt lgkmcnt(0)" ::: "memory"); __builtin_amdgcn_s_barrier(); asm volatile("" ::: "memory");
        if (tid < 256) { const f32x4 pv = *(const LAS f32x4*)(P + tid * 4);
            __hip_atomic_store(xbuf + (size_t)(u.pm * 8 + u.pn) * 256 + tid, (pv[0] + pv[1]) + (pv[2] + pv[3]), __ATOMIC_RELAXED, __HIP_MEMORY_SCOPE_AGENT); }
        asm volatile("s_waitcnt vmcnt(0)" ::: "memory"); __builtin_amdgcn_s_barrier(); asm volatile("" ::: "memory");
        if (tid == 0) {
            __builtin_amdgcn_fence(__ATOMIC_RELEASE, "agent");
            __hip_atomic_fetch_add(cnt + 64 * u.pm, 1u, __ATOMIC_RELAXED, __HIP_MEMORY_SCOPE_AGENT);
            unsigned sp = 0u; while (__hip_atomic_load(cnt + 64 * u.pm, __ATOMIC_RELAXED, __HIP_MEMORY_SCOPE_AGENT) < 8u && sp < (1u << 24)) { __builtin_amdgcn_s_sleep(1); ++sp; }
            __builtin_amdgcn_fence(__ATOMIC_ACQUIRE, "agent");
            flag[0] = 1u;
        }
        asm volatile("s_waitcnt vmcnt(0) lgkmcnt(0)" ::: "memory"); __builtin_amdgcn_s_barrier(); asm volatile("" ::: "memory");
        if (tid < 256) { float tot = 0.f;
#pragma unroll
            for (int t8 = 0; t8 < 8; ++t8) tot += __hip_atomic_load(xbuf + (size_t)(u.pm * 8 + t8) * 256 + tid, __ATOMIC_RELAXED, __HIP_MEMORY_SCOPE_AGENT);
            RN[tid] = rsqrtf(tot * (1.f / DM) + EPS); }
        asm volatile("s_waitcnt vmcnt(0) lgkmcnt(0)" ::: "memory"); __builtin_amdgcn_s_barrier(); asm volatile("" ::: "memory");
        const int col0 = u.pn * BM + wc * 32 + 4 * fq;
#pragma unroll
        for (int ai = 0; ai < 2; ++ai)
#pragma unroll
            for (int m = 0; m < 4; ++m) {
                const int rl = ai * HALF + wr * 64 + m * 16 + fr, q = u.pm * BM + rl; const float rn = RN[rl];
                const int R = (q >> 12) * NPT + 16 + (q & 4095);
                const bf16_t* xp = x1 + (size_t)R * DM + col0; float* yp = yout + (size_t)q * DM + col0;
#pragma unroll
                for (int bj = 0; bj < 2; ++bj)
#pragma unroll
                    for (int n = 0; n < 2; ++n) { const int co = bj * HALF + n * 16; const u32x2 xr2 = *(const u32x2*)(xp + co); const f32x4 gg = *(const f32x4*)(g + col0 + co);
                        const f32x4 xv = (f32x4){bflo(xr2.x), bfhi(xr2.x), bflo(xr2.y), bfhi(xr2.y)};
                        *(f32x4*)(yp + co) = xv + acc[ai][bj][m][n] * rn * gg; }
            }
    }
};
struct EpiMix {
    static constexpr bool PERM = false;
    bf16_t* x1; const float* xp; const float* g; float* xbuf; unsigned* cnt; LAS float* ex;
    __device__ __forceinline__ void operator()(const f32x4 (&acc)[2][2][4][2], const Unit& u, int wr, int wc, int fr, int fq) const {
        const int tid = threadIdx.x;
        LAS float* P = ex; LAS float* RN = ex + 1024;
#pragma unroll
        for (int ai = 0; ai < 2; ++ai)
#pragma unroll
            for (int m = 0; m < 4; ++m) { float ss = 0.f;
#pragma unroll
                for (int bj = 0; bj < 2; ++bj)
#pragma unroll
                    for (int n = 0; n < 2; ++n) { const f32x4 v = acc[ai][bj][m][n]; ss += (v[0] * v[0] + v[1] * v[1]) + (v[2] * v[2] + v[3] * v[3]); }
                ss += __shfl_xor(ss, 16); ss += __shfl_xor(ss, 32);
                if (fq == 0) P[(ai * HALF + wr * 64 + m * 16 + fr) * 4 + wc] = ss; }
        asm volatile("s_waitcnt lgkmcnt(0)" ::: "memory"); __builtin_amdgcn_s_barrier(); asm volatile("" ::: "memory");
        if (tid < 256) { const f32x4 pv = *(const LAS f32x4*)(P + tid * 4);
            __hip_atomic_store(xbuf + (size_t)(u.pm * 8 + u.pn) * 256 + tid, (pv[0] + pv[1]) + (pv[2] + pv[3]), __ATOMIC_RELAXED, __HIP_MEMORY_SCOPE_AGENT); }
        asm volatile("s_waitcnt vmcnt(0)" ::: "memory"); __builtin_amdgcn_s_barrier(); asm volatile("" ::: "memory");
        if (tid == 0) {
            __builtin_amdgcn_fence(__ATOMIC_RELEASE, "agent");
            __hip_atomic_fetch_add(cnt + 64 * u.pm, 1u, __ATOMIC_RELAXED, __HIP_MEMORY_SCOPE_AGENT);
            unsigned sp = 0u; while (__hip_atomic_load(cnt + 64 * u.pm, __ATOMIC_RELAXED, __HIP_MEMORY_SCOPE_AGENT) < 8u && sp < (1u << 24)) { __builtin_amdgcn_s_sleep(1); ++sp; }
            __builtin_amdgcn_fence(__ATOMIC_ACQUIRE, "agent");
        }
        asm volatile("s_waitcnt vmcnt(0) lgkmcnt(0)" ::: "memory"); __builtin_amdgcn_s_barrier(); asm volatile("" ::: "memory");
        if (tid < 256) { float tot = 0.f;
#pragma unroll
            for (int t8 = 0; t8 < 8; ++t8) tot += __hip_atomic_load(xbuf + (size_t)(u.pm * 8 + t8) * 256 + tid, __ATOMIC_RELAXED, __HIP_MEMORY_SCOPE_AGENT);
            RN[tid] = rsqrtf(tot * (1.f / DM) + EPS); }
        asm volatile("s_waitcnt vmcnt(0) lgkmcnt(0)" ::: "memory"); __builtin_amdgcn_s_barrier(); asm volatile("" ::: "memory");
        const int col0 = u.pn * BM + wc * 32 + 4 * fq;
#pragma unroll
        for (int ai = 0; ai < 2; ++ai)
#pragma unroll
            for (int m = 0; m < 4; ++m) {
                const int rl = ai * HALF + wr * 64 + m * 16 + fr, q = u.pm * BM + rl; const float rn = RN[rl];
                const int R = (q >> 12) * NPT + 16 + (q & 4095);
                const float* xrp = xp + (size_t)q * DM + col0; bf16_t* op = x1 + (size_t)R * DM + col0;
#pragma unroll
                for (int bj = 0; bj < 2; ++bj)
#pragma unroll
                    for (int n = 0; n < 2; ++n) { const int co = bj * HALF + n * 16; const f32x4 xv = *(const f32x4*)(xrp + co), gg = *(const f32x4*)(g + col0 + co);
                        const f32x4 o = xv + acc[ai][bj][m][n] * rn * gg; u32x2 w; w.x = cvt_pk_bf16(o[0], o[1]); w.y = cvt_pk_bf16(o[2], o[3]); *(u32x2*)(op + co) = w; }
            }
    }
};
struct EpiGate {
    static constexpr bool PERM = true;
    bf16_t* F; const float* wcf; const float* st_ffn; float* outb; LAS float* exch;
    __device__ __forceinline__ void operator()(const f32x4 (&acc)[2][2][4][2], const Unit& u, int wr, int wc, int fr, int fq) const {
        const int lane = fr + 16 * fq;
        if (fr >= 14) {
#pragma unroll
            for (int ai = 0; ai < 2; ++ai)
#pragma unroll
                for (int n = 0; n < 2; ++n) *(LAS f32x4*)(exch + (((((ai * 2 + wr) * 4 + wc) * 2 + (fr - 14)) * 2 + n) * 16) + fq * 4) = acc[ai][0][3][n];
        }
        asm volatile("s_waitcnt lgkmcnt(0)" ::: "memory"); __builtin_amdgcn_s_barrier(); asm volatile("" ::: "memory");
        const int j0 = u.pn * 128 + wc * 32 + 8 * fq;
        f32x4 w0[2], w1[2], w2[2];
#pragma unroll
        for (int n = 0; n < 2; ++n) { w0[n] = *(const f32x4*)(wcf + j0 + 4 * n); w1[n] = *(const f32x4*)(wcf + DFF + j0 + 4 * n); w2[n] = *(const f32x4*)(wcf + 2 * DFF + j0 + 4 * n); }
        const int src1 = (lane & 48) | ((fr - 1) & 15), src2 = (lane & 48) | ((fr - 2) & 15);
#pragma unroll
        for (int ai = 0; ai < 2; ++ai) {
            const int sl = 2 * ai + wr;
            f32x4 gprev[2];
#pragma unroll
            for (int n = 0; n < 2; ++n) { gprev[n] = (f32x4){0.f, 0.f, 0.f, 0.f};
                if (sl > 0 && fr >= 14) gprev[n] = *(const LAS f32x4*)(exch + ((((sl - 1) * 4 + wc) * 2 + (fr - 14)) * 2 + n) * 16 + fq * 4); }
#pragma unroll
            for (int m = 0; m < 4; ++m) {
                const int lr = ai * HALF + wr * 64 + m * 16 + fr, R = u.pm * 254 - 2 + lr;
                int t, Tseq, sq; bool samp = false;
                if (R < ROWS_P) { sq = R / NPT; t = R - sq * NPT; Tseq = NPT; if (R < 0) { sq = 0; t = 100; } }
                else { samp = true; sq = (R - ROWS_P) >> 4; t = (R - ROWS_P) & 15; Tseq = 16; }
                const bool valid = (lr >= 2) && (R < ROWS_V);
                u32x4 pk;
#pragma unroll
                for (int n = 0; n < 2; ++n) {
                    const f32x4 cur = acc[ai][0][m][n]; const f32x4 pm = (m == 0) ? gprev[n] : acc[ai][0][m == 0 ? 0 : m - 1][n];
                    f32x4 p1, p2;
#pragma unroll
                    for (int i = 0; i < 4; ++i) { const float r1 = (fr == 15) ? pm[i] : cur[i], r2 = (fr >= 14) ? pm[i] : cur[i]; p1[i] = __shfl(r1, src1); p2[i] = __shfl(r2, src2); }
                    if (valid && t < 2) {
                        f32x4 h0 = (f32x4){0.f, 0.f, 0.f, 0.f}, h1 = h0;
                        if (samp) { h0 = *(const f32x4*)(st_ffn + ((size_t)sq * 2 + 0) * DFF + j0 + 4 * n); h1 = *(const f32x4*)(st_ffn + ((size_t)sq * 2 + 1) * DFF + j0 + 4 * n); }
                        if (t == 0) { p1 = h1; p2 = h0; } else { p2 = h1; }
                    }
                    const f32x4 gc = w0[n] * p2 + w1[n] * p1 + w2[n] * cur; const f32x4 vv = acc[ai][1][m][n];
                    const float f0 = silu_f(gc[0]) * vv[0], f1 = silu_f(gc[1]) * vv[1], f2 = silu_f(gc[2]) * vv[2], f3 = silu_f(gc[3]) * vv[3];
                    if (n == 0) { pk.x = cvt_pk_bf16(f0, f1); pk.y = cvt_pk_bf16(f2, f3); } else { pk.z = cvt_pk_bf16(f0, f1); pk.w = cvt_pk_bf16(f2, f3); }
                    if (valid && t >= Tseq - 2) { float* d = outb + (samp ? O_NFC_S : O_NFC_P) + ((size_t)sq * 2 + (t - (Tseq - 2))) * DFF + j0 + 4 * n; *(f32x4*)d = cur; }
                }
                if (valid && (samp || t >= 16)) { const int frow = samp ? 16384 + (R - ROWS_P) : sq * 4096 + (t - 16); *(u32x4*)(F + (size_t)frow * DFF + j0) = pk; }
            }
        }
    }
};
}

__device__ __forceinline__ void transpose_item(const float* W, int ldw, int k0, int n0, bf16_t* WT, int K, int drow0, LAS float* scr, int lane) {
#pragma unroll 8
    for (int i = 0; i < 32; ++i) { const int kk = 2 * i + (lane >> 5); scr[kk * 33 + (lane & 31)] = W[(size_t)(k0 + kk) * ldw + n0 + (lane & 31)]; }
    LDS_WAIT();
    const int c = lane & 7;
#pragma unroll
    for (int j = 0; j < 4; ++j) { const int n = (lane >> 3) + 8 * j; const LAS float* s = scr + (8 * c) * 33 + n;
        u32x4 o; o.x = cvt_pk_bf16(s[0 * 33], s[1 * 33]); o.y = cvt_pk_bf16(s[2 * 33], s[3 * 33]); o.z = cvt_pk_bf16(s[4 * 33], s[5 * 33]); o.w = cvt_pk_bf16(s[6 * 33], s[7 * 33]);
        *(u32x4*)(WT + (size_t)(drow0 + n) * K + k0 + 8 * c) = o; }
    LDS_WAIT();
}
__device__ __forceinline__ void transpose_issue(float (&r)[32], const float* W, int ldw, int k0, int n0, int lane) {
#pragma unroll
    for (int i = 0; i < 32; ++i) { const int kk = 2 * i + (lane >> 5); r[i] = W[(size_t)(k0 + kk) * ldw + n0 + (lane & 31)]; }
}
__device__ __forceinline__ void transpose_finish(const float (&r)[32], bf16_t* WT, int K, int k0, int drow0, LAS float* scr, int lane) {
#pragma unroll
    for (int i = 0; i < 32; ++i) { const int kk = 2 * i + (lane >> 5); scr[kk * 33 + (lane & 31)] = r[i]; }
    LDS_WAIT();
    const int c = lane & 7;
#pragma unroll
    for (int j = 0; j < 4; ++j) { const int n = (lane >> 3) + 8 * j; const LAS float* s = scr + (8 * c) * 33 + n;
        u32x4 o; o.x = cvt_pk_bf16(s[0 * 33], s[1 * 33]); o.y = cvt_pk_bf16(s[2 * 33], s[3 * 33]); o.z = cvt_pk_bf16(s[4 * 33], s[5 * 33]); o.w = cvt_pk_bf16(s[6 * 33], s[7 * 33]);
        *(u32x4*)(WT + (size_t)(drow0 + n) * K + k0 + 8 * c) = o; }
    LDS_WAIT();
}
__device__ __forceinline__ void norm_store_bf16(const f32x4 (&v)[8], const float* g, bf16_t* orow, int lane) {
    float s = 0.f;
#pragma unroll
    for (int j = 0; j < 8; ++j) s += (v[j][0] * v[j][0] + v[j][1] * v[j][1]) + (v[j][2] * v[j][2] + v[j][3] * v[j][3]);
    const float r = rsqrtf(wave_sum(s) * (1.f / DM) + EPS);
#pragma unroll
    for (int j = 0; j < 8; ++j) { const f32x4 gg = *(const f32x4*)(g + 4 * lane + 256 * j); const f32x4 o = v[j] * r * gg;
        u32x2 w; w.x = cvt_pk_bf16(o[0], o[1]); w.y = cvt_pk_bf16(o[2], o[3]); *(u32x2*)(orow + 4 * lane + 256 * j) = w; }
}

template <int I> __device__ __forceinline__ void subst_row(float (&x)[64], const LAS float* Mm, float r) {
#pragma unroll
    for (int j4 = 0; j4 < I; j4 += 4) { const f32x4 mv = *(const LAS f32x4*)(Mm + I * 64 + j4);
#pragma unroll
        for (int e = 0; e < 4; ++e) if (j4 + e < I) r -= mv[e] * x[j4 + e]; }
    x[I] = r;
    __builtin_amdgcn_sched_barrier(0);
}
template <int I> struct SubstAll {
    static __device__ __forceinline__ void run(float (&x)[64], const LAS float* Mm, const LAS bf16_t* srcc, const LAS float* scl) {
        SubstAll<I - 1>::run(x, Mm, srcc, scl);
        subst_row<I>(x, Mm, bf2f(srcc[I * 136]) * scl[I]);
    }
};
template <> struct SubstAll<-1> { static __device__ __forceinline__ void run(float (&)[64], const LAS float*, const LAS bf16_t*, const LAS float*) {} };

#define GDN_STEP_BODY(LD8, LD4) \
    bf16x8 Sb[4]; \
    _Pragma("unroll") for (int kb = 0; kb < 4; ++kb) { u32x4 w; w.x = cvt_pk_bf16(S[2 * kb][0], S[2 * kb][1]); w.y = cvt_pk_bf16(S[2 * kb][2], S[2 * kb][3]); w.z = cvt_pk_bf16(S[2 * kb + 1][0], S[2 * kb + 1][1]); w.w = cvt_pk_bf16(S[2 * kb + 1][2], S[2 * kb + 1][3]); \
        Sb[kb] = __builtin_bit_cast(bf16x8, w); } \
    bf16x8 fa[16]; u32x2 ur[4]; \
    _Pragma("unroll") for (int tt = 0; tt < 4; ++tt) { _Pragma("unroll") for (int kb = 0; kb < 4; ++kb) fa[4 * tt + kb] = LD8(Wg + (16 * tt + fr) * 128 + 32 * kb + 8 * fq); ur[tt] = LD4(Us + fr * 64 + 16 * tt + 4 * fq); } \
    f32x4 vn[4]; \
    { f32x4 P[4]; \
      _Pragma("unroll") for (int tt = 0; tt < 4; ++tt) P[tt] = (f32x4){0.f, 0.f, 0.f, 0.f}; \
      _Pragma("unroll") for (int kb = 0; kb < 4; ++kb) _Pragma("unroll") for (int tt = 0; tt < 4; ++tt) P[tt] = __builtin_amdgcn_mfma_f32_16x16x32_bf16(fa[4 * tt + kb], Sb[kb], P[tt], 0, 0, 0); \
      _Pragma("unroll") for (int tt = 0; tt < 4; ++tt) { vn[tt][0] = bflo(ur[tt].x) - P[tt][0]; vn[tt][1] = bfhi(ur[tt].x) - P[tt][1]; vn[tt][2] = bflo(ur[tt].y) - P[tt][2]; vn[tt][3] = bfhi(ur[tt].y) - P[tt][3]; } } \
    _Pragma("unroll") for (int tt = 0; tt < 4; ++tt) _Pragma("unroll") for (int kb = 0; kb < 4; ++kb) fa[4 * tt + kb] = LD8(Wg + 8192 + (16 * tt + fr) * 128 + 32 * kb + 8 * fq); \
    bf16x8 fb[6]; \
    fb[0] = LD8(Wg + 24576 + (fr) * 64 + 8 * fq); fb[1] = LD8(Wg + 24576 + (16 + fr) * 64 + 8 * fq); \
    fb[2] = LD8(Wg + 24576 + (32 + fr) * 64 + 8 * fq); fb[3] = LD8(Wg + 24576 + (32 + fr) * 64 + 32 + 8 * fq); \
    fb[4] = LD8(Wg + 24576 + (48 + fr) * 64 + 8 * fq); fb[5] = LD8(Wg + 24576 + (48 + fr) * 64 + 32 + 8 * fq); \
    bf16x8 Vb2[2]; \
    _Pragma("unroll") for (int k2 = 0; k2 < 2; ++k2) { u32x4 w; w.x = cvt_pk_bf16(vn[2 * k2][0], vn[2 * k2][1]); w.y = cvt_pk_bf16(vn[2 * k2][2], vn[2 * k2][3]); w.z = cvt_pk_bf16(vn[2 * k2 + 1][0], vn[2 * k2 + 1][1]); w.w = cvt_pk_bf16(vn[2 * k2 + 1][2], vn[2 * k2 + 1][3]); \
        Vb2[k2] = __builtin_bit_cast(bf16x8, w); } \
    f32x4 O[4]; \
    _Pragma("unroll") for (int tt = 0; tt < 4; ++tt) O[tt] = (f32x4){0.f, 0.f, 0.f, 0.f}; \
    _Pragma("unroll") for (int kb = 0; kb < 4; ++kb) _Pragma("unroll") for (int tt = 0; tt < 4; ++tt) O[tt] = __builtin_amdgcn_mfma_f32_16x16x32_bf16(fa[4 * tt + kb], Sb[kb], O[tt], 0, 0, 0); \
    O[0] = __builtin_amdgcn_mfma_f32_16x16x32_bf16(fb[0], Vb2[0], O[0], 0, 0, 0); O[1] = __builtin_amdgcn_mfma_f32_16x16x32_bf16(fb[1], Vb2[0], O[1], 0, 0, 0); \
    O[2] = __builtin_amdgcn_mfma_f32_16x16x32_bf16(fb[2], Vb2[0], O[2], 0, 0, 0); O[2] = __builtin_amdgcn_mfma_f32_16x16x32_bf16(fb[3], Vb2[1], O[2], 0, 0, 0); \
    O[3] = __builtin_amdgcn_mfma_f32_16x16x32_bf16(fb[4], Vb2[0], O[3], 0, 0, 0); O[3] = __builtin_amdgcn_mfma_f32_16x16x32_bf16(fb[5], Vb2[1], O[3], 0, 0, 0); \
    _Pragma("unroll") for (int dt = 0; dt < 8; ++dt) _Pragma("unroll") for (int k2 = 0; k2 < 2; ++k2) fa[2 * dt + k2] = LD8(Wg + 16384 + (16 * dt + fr) * 64 + 32 * k2 + 8 * fq); \
    if (tok0 >= 0 && tok0 + 64 <= Tseq) { \
        _Pragma("unroll") for (int tt = 0; tt < 4; ++tt) _Pragma("unroll") for (int jj = 0; jj < 4; ++jj) obase[(size_t)(tok0 + 16 * tt + 4 * fq + jj) * 1024] = O[tt][jj]; \
    } else { \
        _Pragma("unroll") for (int tt = 0; tt < 4; ++tt) _Pragma("unroll") for (int jj = 0; jj < 4; ++jj) { const int tk = tok0 + 16 * tt + 4 * fq + jj; if (tk >= 0 && tk < Tseq) obase[(size_t)tk * 1024] = O[tt][jj]; } \
    } \
    _Pragma("unroll") for (int dt = 0; dt < 8; ++dt) S[dt] = S[dt] * egl; \
    _Pragma("unroll") for (int k2 = 0; k2 < 2; ++k2) _Pragma("unroll") for (int dt = 0; dt < 8; ++dt) S[dt] = __builtin_amdgcn_mfma_f32_16x16x32_bf16(fa[2 * dt + k2], Vb2[k2], S[dt], 0, 0, 0);
__device__ __forceinline__ void gdn_step_lds(f32x4 (&S)[8], const LAS bf16_t* Wg, const LAS bf16_t* Us, float egl, float* obase, int tok0, int Tseq, int fr, int fq) {
#define LD8L(p) (*(const LAS bf16x8*)(p))
#define LD4L(p) (*(const LAS u32x2*)(p))
    GDN_STEP_BODY(LD8L, LD4L)
}
__device__ __forceinline__ void gdn_step_glb(f32x4 (&S)[8], const bf16_t* Wg, const bf16_t* Us, float egl, float* obase, int tok0, int Tseq, int fr, int fq) {
#define LD8G(p) (*(const bf16x8*)(p))
#define LD4G(p) (*(const u32x2*)(p))
    GDN_STEP_BODY(LD8G, LD4G)
}

#define XB_TMO      128
#define XB_XCNT(j)  (256  + 64 * (j))
#define XB_XSUB(j)  (1280 + 64 * (j))
#define XB_XGEN(j)  (2304 + 64 * (j))
#define XB_TOP      3328
#define XB_TOPGEN   3392
#define XCD_BAR_WORDS 3456
#define XB_SPIN_CAP (1u << 22)
__device__ __forceinline__ unsigned xb_ld(unsigned* p)              { return __hip_atomic_load(p, __ATOMIC_RELAXED, __HIP_MEMORY_SCOPE_AGENT); }
__device__ __forceinline__ unsigned xb_add(unsigned* p, unsigned v) { return __hip_atomic_fetch_add(p, v, __ATOMIC_RELAXED, __HIP_MEMORY_SCOPE_AGENT); }
__device__ __forceinline__ unsigned xb_xcc_id() { return (unsigned)__builtin_amdgcn_s_getreg((3 << 11) | 20) & 0xFu; }
#define XB_SPIN(cond, bar) do { unsigned _sp = 0; while (cond) { __builtin_amdgcn_s_sleep(1); \
    if ((++_sp & 255u) == 0u) { if (xb_ld(&(bar)[XB_TMO])) break; if (_sp > XB_SPIN_CAP) { atomicAdd(&(bar)[XB_TMO], 1u); break; } } } } while (0)
struct XcdBarrier { unsigned* bar; unsigned x; volatile LAS unsigned* st; };
__device__ __forceinline__ XcdBarrier xcd_barrier_post(unsigned* bar, volatile LAS unsigned* st) {
    XcdBarrier b; b.bar = bar; b.x = xb_xcc_id(); b.st = st;
    if (threadIdx.x == 0) (void)xb_add(&bar[XB_XCNT(b.x)], 1u);
    return b;
}
__device__ __forceinline__ void xcd_barrier_complete(unsigned* bar, unsigned x, unsigned& nloc, unsigned& nx) {
    const unsigned G = gridDim.x * gridDim.y * gridDim.z;
    unsigned sum, cnt, mine, sp = 0u;
    for (;;) {
        sum = 0u; cnt = 0u; mine = 0u;
#pragma unroll
        for (unsigned j = 0; j < 16; ++j) { const unsigned c = xb_ld(&bar[XB_XCNT(j)]); sum += c; cnt += (c > 0u) ? 1u : 0u; mine = (j == x) ? c : mine; }
        if (sum == G) break;
        __builtin_amdgcn_s_sleep(1);
        if ((++sp & 255u) == 0u) { if (xb_ld(&bar[XB_TMO])) break; if (sp > XB_SPIN_CAP) { atomicAdd(&bar[XB_TMO], 1u); break; } }
    }
    nloc = mine > 0u ? mine : 1u; nx = cnt > 0u ? cnt : 1u;
}
__device__ __forceinline__ void xcd_barrier(const XcdBarrier& b) {
    asm volatile("s_waitcnt vmcnt(0)" ::: "memory");
    __syncthreads();
    if (threadIdx.x == 0) {
        unsigned* bar = b.bar;
        __builtin_amdgcn_s_waitcnt(0);
        unsigned nloc = b.st[0], nx = b.st[1];
        if (nloc == 0u) { xcd_barrier_complete(bar, b.x, nloc, nx); b.st[0] = nloc; b.st[1] = nx; }
        const unsigned old = xb_add(&bar[XB_XSUB(b.x)], 1u);
        const unsigned gen = old / nloc;
        if (old + 1u == (gen + 1u) * nloc) {
            __builtin_amdgcn_fence(__ATOMIC_RELEASE, "agent");
            asm volatile("s_waitcnt vmcnt(0)" ::: "memory");
            const unsigned og = xb_add(&bar[XB_TOP], 1u);
            const unsigned tg = og / nx;
            if (og + 1u == (tg + 1u) * nx) xb_add(&bar[XB_TOPGEN], 1u);
            else XB_SPIN(xb_ld(&bar[XB_TOPGEN]) == tg, bar);
            __builtin_amdgcn_fence(__ATOMIC_ACQUIRE, "agent");
            xb_add(&bar[XB_XGEN(b.x)], 1u);
            asm volatile("s_waitcnt vmcnt(0)" ::: "memory");
        } else {
            XB_SPIN(xb_ld(&bar[XB_XGEN(b.x)]) == gen, bar);
            __builtin_amdgcn_fence(__ATOMIC_ACQUIRE, "agent");
            asm volatile("s_waitcnt vmcnt(0)" ::: "memory");
        }
    }
    __syncthreads();
}

__global__ void __launch_bounds__(512, 2) hymba_fwd(Params p) {
    extern __shared__ __attribute__((aligned(16))) unsigned char lds_raw[];
    LAS unsigned char* lds = (LAS unsigned char*)lds_raw;
    const int G = gridDim.x, bx = blockIdx.x, NGW = G * 8, NGT = G * 512;
#define PHASE_LOCALS int tid = threadIdx.x; asm volatile("" : "+v"(tid)); const int lane = tid & 63, wave = __builtin_amdgcn_readfirstlane(tid >> 6), gw = bx * 8 + wave, gtid = bx * 512 + tid; (void)gw; (void)gtid; (void)lane;
    unsigned char* ws = p.ws;
    bf16_t* Wt_in = (bf16_t*)(ws + WS_WIN); bf16_t* Wt_down = (bf16_t*)(ws + WS_WDOWN); bf16_t* Wt_out = (bf16_t*)(ws + WS_WOUT); bf16_t* Wt_up = (bf16_t*)(ws + WS_WUP);
    bf16_t* Bm = (bf16_t*)(ws + WS_B) + 2 * DM;
    bf16_t* PROJ = (bf16_t*)(ws + WS_C); float* OBUF = (float*)(ws + WS_C); bf16_t* MOb = (bf16_t*)(ws + WS_C); bf16_t* FOb = (bf16_t*)(ws + WS_B); bf16_t* Fb = (bf16_t*)(ws + WS_F);
    bf16_t* Zb = (bf16_t*)(ws + WS_Z); float* AB = (float*)(ws + WS_AB); float* PART = (float*)(ws + WS_PART); float* EGL = (float*)(ws + WS_EGL);
    unsigned char* GDN = ws + WS_GDN; bf16_t* X1 = (bf16_t*)(ws + WS_X1);
    float* out = p.out;
    if (threadIdx.x < 2) ((volatile LAS unsigned*)(lds + LDS_BYTES - 64))[threadIdx.x] = 0u;
    __syncthreads();
    const XcdBarrier xbar = xcd_barrier_post((unsigned*)ws, (volatile LAS unsigned*)(lds + LDS_BYTES - 64));

    PH(0) {
        PHASE_LOCALS
        LAS float* scr = (LAS float*)(lds + wave * 8448);
        constexpr int I_IN = 32 * 224, I_OUT = 32 * 64;
        for (int it = gw; it < I_IN + I_OUT; it += NGW) {
            if (it < I_IN) { const int kb = it / 224, nb = it - kb * 224; transpose_item(p.w_in, INC, 64 * kb, 32 * nb, Wt_in, DM, 32 * nb, scr, lane); }
            else { const int r = it - I_IN, kb = r >> 6, nb = r & 63; transpose_item(p.w_out, DM, 64 * kb, 32 * nb, Wt_out, DM, 32 * nb, scr, lane); }
        }
        for (int idx = gtid; idx < 16 * DM; idx += NGT) { const int n = idx >> 11, k = idx & 2047; Wt_in[(size_t)(7168 + n) * DM + k] = f2bf(p.w_in[(size_t)k * INC + 7168 + n]); }
        for (int idx = gtid; idx < 240 * DM / 8; idx += NGT) ((u32x4*)(Wt_in + (size_t)7184 * DM))[idx] = (u32x4){0u, 0u, 0u, 0u};
        {
            f32x4 nx[8]; const float* xr = x_row(p, gw);
#pragma unroll
            for (int j = 0; j < 8; ++j) nx[j] = xr ? *(const f32x4*)(xr + 4 * lane + 256 * j) : (f32x4){0.f, 0.f, 0.f, 0.f};
#pragma unroll 1
            for (int R = gw; R < T_PAD; R += NGW) {
                f32x4 v[8]; const bool live = xr != nullptr;
#pragma unroll
                for (int j = 0; j < 8; ++j) v[j] = nx[j];
                xr = (R + NGW < T_PAD) ? x_row(p, R + NGW) : nullptr;
                if (xr) {
#pragma unroll
                    for (int j = 0; j < 8; ++j) nx[j] = *(const f32x4*)(xr + 4 * lane + 256 * j);
                }
                bf16_t* orow = Bm + (size_t)R * DM;
                if (live) norm_store_bf16(v, p.g_pre_mix, orow, lane);
                else {
#pragma unroll
                    for (int j = 0; j < 8; ++j) *(u32x2*)(orow + 4 * lane + 256 * j) = (u32x2){0u, 0u};
                }
            }
        }
    }
    xcd_barrier(xbar);

    PH(1) {
        PHASE_LOCALS
        pg8::Gemm g{Bm, Wt_in, DM, (size_t)256 * DM * 2}; pg8::StaticOrder S; S.init(65, 29, G, bx);
        pg8::EpiProj E{PROJ, Zb, AB};
        pg8::gemm_phase<pg8::EpiProj>(lds, g, S, E);
    }
    xcd_barrier(xbar);

    PH(2) {
        PHASE_LOCALS
        const int half = tid >> 8, t = tid & 255, hw = wave & 3;
        LAS unsigned char* L = lds + half * 70656;
        LAS bf16_t* Kb = (LAS bf16_t*)L; LAS bf16_t* Qb = (LAS bf16_t*)(L + 17408); LAS bf16_t* Vb = (LAS bf16_t*)(L + 34816);
        LAS float* Mm = (LAS float*)(L + 52224); LAS float* gc = (LAS float*)(L + 68608); LAS float* bt = gc + 64; LAS float* eg = gc + 128; LAS float* bw = gc + 192; LAS float* kdv = gc + 256;
        const int fr = lane & 15, fq = lane >> 4;
        for (int pr = bx; pr < NITEM / 2; pr += G) {
            const int item = 2 * pr + half;
            int h, tok0, Tseq, rowbase, sidx; bool samp;
            if (item < NITEM_P) { const int bh = item / 65, c = item - bh * 65; sidx = bh >> 3; h = bh & 7; tok0 = 64 * c - 48; Tseq = NPT; rowbase = sidx * NPT; samp = false; }
            else { const int sh = item - NITEM_P; sidx = sh >> 3; h = sh & 7; tok0 = 0; Tseq = 16; rowbase = ROWS_P + 16 * sidx; samp = true; }
            unsigned char* blob = GDN + (size_t)item * BLOB;
            bf16_t* Wg = (bf16_t*)blob; bf16_t* QGg = Wg + 8192; bf16_t* KDTg = Wg + 16384; bf16_t* ATTg = Wg + 24576; bf16_t* UTg = Wg + 28672;
            if (t < 64) {
                const int tk = tok0 + t; float gval = 0.f, bval = 0.f;
                if (tk >= 0 && tk < Tseq) { const float* abr = AB + (size_t)(rowbase + tk) * 16; const float bl = abr[h], al = abr[8 + h] + p.dt_bias[h];
                    bval = 1.f / (1.f + __expf(-bl)); const float sp = al > 20.f ? al : log1pf(__expf(al)); gval = -__expf(p.a_log[h]) * sp; }
                float cs = gval;
#pragma unroll
                for (int o = 1; o < 64; o <<= 1) { const float y = __shfl_up(cs, o); if (lane >= o) cs += y; }
                gc[t] = cs; bt[t] = bval; eg[t] = __expf(cs); bw[t] = bval * __expf(cs); kdv[t] = __expf(__shfl(cs, 63) - cs);
            }
            { LAS float* wl = Mm;
#pragma unroll
              for (int i = 0; i < 6; ++i) { const int v = t + 256 * i, j = v / 384, r = v - j * 384; wl[v] = p.w_conv_gdn[(size_t)j * 3072 + (r >> 7) * 1024 + h * 128 + (r & 127)]; } }
            __syncthreads();
            P2(0)
#pragma unroll 1
            for (int ib = 0; ib < 3; ++ib) {
                u32x4 raw[4][4];
#pragma unroll
                for (int u = 0; u < 4; ++u) {
                    const int idx = t + 256 * (4 * ib + u), pp = idx / 48, oct = idx - pp * 48, cq = (oct >> 4) * 1024 + h * 128 + (oct & 15) * 8;
                    const int tk = tok0 + pp;
#pragma unroll
                    for (int j = 0; j < 4; ++j) { int tj = tk - j; tj = tj < 0 ? 0 : (tj >= Tseq ? Tseq - 1 : tj);
                        raw[u][j] = *(const u32x4*)(PROJ + (size_t)(rowbase + tj) * 6144 + 3072 + cq);
}
                }
#pragma unroll
                for (int u = 0; u < 4; ++u) {
                    const int idx = t + 256 * (4 * ib + u), pp = idx / 48, oct = idx - pp * 48, which = oct >> 4, d0 = (oct & 15) * 8, cq = which * 1024 + h * 128 + d0;
                    const int tk = tok0 + pp; const bool valid = (tk >= 0 && tk < Tseq);
                    float y[8];
#pragma unroll
                    for (int e = 0; e < 8; ++e) y[e] = 0.f;
#pragma unroll
                    for (int j = 0; j < 4; ++j) { const float m = (tk - j >= 0) ? 1.f : 0.f; const u32x4 r = raw[u][j]; const LAS float* wlp = Mm + (3 - j) * 384 + which * 128 + d0; const f32x4 wa = *(const LAS f32x4*)wlp * m, wb = *(const LAS f32x4*)(wlp + 4) * m;
                        y[0] += wa[0] * bflo(r.x); y[1] += wa[1] * bfhi(r.x); y[2] += wa[2] * bflo(r.y); y[3] += wa[3] * bfhi(r.y); y[4] += wb[0] * bflo(r.z); y[5] += wb[1] * bfhi(r.z); y[6] += wb[2] * bflo(r.w); y[7] += wb[3] * bfhi(r.w); }
                    if (samp && valid && tk < 3) {
#pragma unroll
                        for (int j = 1; j < 4; ++j) if (tk - j < 0) { const float* hp = p.st_gdn_conv + ((size_t)sidx * 3 + (3 + tk - j)) * 3072 + cq; const f32x4 a = *(const f32x4*)hp, bq = *(const f32x4*)(hp + 4);
                            const LAS float* wlp = Mm + (3 - j) * 384 + which * 128 + d0; const f32x4 wa = *(const LAS f32x4*)wlp, wb = *(const LAS f32x4*)(wlp + 4);
                            y[0] += wa[0] * a[0]; y[1] += wa[1] * a[1]; y[2] += wa[2] * a[2]; y[3] += wa[3] * a[3];
                            y[4] += wb[0] * bq[0]; y[5] += wb[1] * bq[1]; y[6] += wb[2] * bq[2]; y[7] += wb[3] * bq[3]; }
                    }
                    float ss = 0.f;
#pragma unroll
                    for (int e = 0; e < 8; ++e) { y[e] = valid ? silu_f(y[e]) : 0.f; ss += y[e] * y[e]; }
                    ss += __shfl_xor(ss, 1); ss += __shfl_xor(ss, 2); ss += __shfl_xor(ss, 4); ss += __shfl_xor(ss, 8);
                    float sc = 1.f;
                    if (which == 0) sc = rsqrtf(ss + EPS) * 0.08838834764831845f; else if (which == 1) sc = rsqrtf(ss + EPS);
                    u32x4 o; o.x = cvt_pk_bf16(y[0] * sc, y[1] * sc); o.y = cvt_pk_bf16(y[2] * sc, y[3] * sc); o.z = cvt_pk_bf16(y[4] * sc, y[5] * sc); o.w = cvt_pk_bf16(y[6] * sc, y[7] * sc);
                    LAS bf16_t* dst = (which == 0 ? Qb : (which == 1 ? Kb : Vb)) + pp * 136 + d0;
                    *(LAS u32x4*)dst = o;
                }
            }
            __syncthreads();
            P2(1) {
                const int ti = hw, i = 16 * ti + fr; const float gi = gc[i], bi = bt[i];
                bf16x8 ka[4], qa[4];
#pragma unroll
                for (int kb = 0; kb < 4; ++kb) { ka[kb] = *(const LAS bf16x8*)(Kb + i * 136 + kb * 32 + fq * 8); qa[kb] = *(const LAS bf16x8*)(Qb + i * 136 + kb * 32 + fq * 8); }
#pragma unroll 1
                for (int tj = 0; tj <= (ti | 1); ++tj) {
                    f32x4 kk = (f32x4){0.f, 0.f, 0.f, 0.f}, qk = kk;
                    if (tj <= ti) {
#pragma unroll
                        for (int kb = 0; kb < 4; ++kb) { const bf16x8 b = *(const LAS bf16x8*)(Kb + (16 * tj + fr) * 136 + kb * 32 + fq * 8);
                            kk = __builtin_amdgcn_mfma_f32_16x16x32_bf16(b, ka[kb], kk, 0, 0, 0); qk = __builtin_amdgcn_mfma_f32_16x16x32_bf16(b, qa[kb], qk, 0, 0, 0); }
                    }
                    const int jb = 16 * tj + 4 * fq; const f32x4 gj = *(const LAS f32x4*)(gc + jb);
                    f32x4 mrow, arow;
#pragma unroll
                    for (int jj = 0; jj < 4; ++jj) { const int j = jb + jj; const float dec = (i >= j) ? __expf(gi - gj[jj]) : 0.f; mrow[jj] = (i > j) ? bi * kk[jj] * dec : 0.f; arow[jj] = qk[jj] * dec; }
                    if (tj <= ti) *(LAS f32x4*)(Mm + i * 64 + jb) = mrow;
                    u32x2 aw; aw.x = cvt_pk_bf16(arow[0], arow[1]); aw.y = cvt_pk_bf16(arow[2], arow[3]);
                    *(u32x2*)(ATTg + i * 64 + (tj >> 1) * 32 + 8 * fq + 4 * (tj & 1)) = aw;
                }
            }
            P2(2) {
#pragma unroll
                for (int i = 0; i < 4; ++i) { const int v = t + 256 * i, tok = v >> 4, oct = v & 15, dkb = (oct >> 2) * 32 + (oct & 3) * 4; const float e = eg[tok];
                    const u32x2 lo = *(const LAS u32x2*)(Qb + tok * 136 + dkb), hi = *(const LAS u32x2*)(Qb + tok * 136 + dkb + 16);
                    u32x4 o; o.x = cvt_pk_bf16(bflo(lo.x) * e, bfhi(lo.x) * e); o.y = cvt_pk_bf16(bflo(lo.y) * e, bfhi(lo.y) * e); o.z = cvt_pk_bf16(bflo(hi.x) * e, bfhi(hi.x) * e); o.w = cvt_pk_bf16(bflo(hi.y) * e, bfhi(hi.y) * e);
                    *(u32x4*)(QGg + tok * 128 + 8 * oct) = o; }
#pragma unroll
                for (int i = 0; i < 4; ++i) { const int v = t + 256 * i, dk = v >> 3, oct = v & 7, tb = (oct >> 2) * 32 + (oct & 3) * 4; float f[8];
#pragma unroll
                    for (int e = 0; e < 8; ++e) { const int tok = tb + (e >> 2) * 16 + (e & 3); f[e] = bf2f(Kb[tok * 136 + dk]) * kdv[tok]; }
                    u32x4 o; o.x = cvt_pk_bf16(f[0], f[1]); o.y = cvt_pk_bf16(f[2], f[3]); o.z = cvt_pk_bf16(f[4], f[5]); o.w = cvt_pk_bf16(f[6], f[7]);
                    *(u32x4*)(KDTg + dk * 64 + 8 * oct) = o; }
                if (t == 0) { const float e63 = eg[63]; EGL[item] = e63; *(f32x4*)(blob + 73728) = (f32x4){e63, e63, e63, e63}; }
            }
            __syncthreads();
            P2(3) {
                float x[64];
                const bool isU = t < 128; const int c = t & 127; const LAS bf16_t* src = isU ? Vb : Kb;
                SubstAll<63>::run(x, Mm, src + c, isU ? bt : bw);
                if (isU) {
#pragma unroll
                    for (int q = 0; q < 8; ++q) { u32x4 o; o.x = cvt_pk_bf16(x[8 * q], x[8 * q + 1]); o.y = cvt_pk_bf16(x[8 * q + 2], x[8 * q + 3]); o.z = cvt_pk_bf16(x[8 * q + 4], x[8 * q + 5]); o.w = cvt_pk_bf16(x[8 * q + 6], x[8 * q + 7]);
                        *(u32x4*)(UTg + c * 64 + 8 * q) = o; }
                } else { const int pc = (c & 96) + perm32(c & 31);
#pragma unroll
                    for (int i = 0; i < 64; ++i) Qb[i * 136 + pc] = f2bf(x[i]); }
            }
            __syncthreads();
#pragma unroll
            for (int i = 0; i < 4; ++i) { const int v = t + 256 * i, row = v >> 4, oct = v & 15; *(u32x4*)(Wg + row * 128 + 8 * oct) = *(const LAS u32x4*)(Qb + row * 136 + 8 * oct); }
            __syncthreads();
        }
        P2(4) for (int grp = gw; grp < ROWS_V / 8; grp += NGW) {
            const int R0 = grp * 8; int sq, t0, Tseq; bool samp;
            if (R0 < ROWS_P) { sq = R0 / NPT; t0 = R0 - sq * NPT; Tseq = NPT; samp = false; } else { sq = (R0 - ROWS_P) >> 4; t0 = (R0 - ROWS_P) & 15; Tseq = 16; samp = true; }
            const int c0 = lane * 16;
            float cm1[16], cm2[16], wa0[16], wa1[16], wa2[16], gna[16];
#pragma unroll
            for (int q = 0; q < 4; ++q) { const f32x4 a0 = *(const f32x4*)(p.w_conv_a + c0 + 4 * q), a1 = *(const f32x4*)(p.w_conv_a + 1024 + c0 + 4 * q), a2 = *(const f32x4*)(p.w_conv_a + 2048 + c0 + 4 * q), gg = *(const f32x4*)(p.g_norm_a + c0 + 4 * q);
#pragma unroll
                for (int e = 0; e < 4; ++e) { wa0[4 * q + e] = a0[e]; wa1[4 * q + e] = a1[e]; wa2[4 * q + e] = a2[e]; gna[4 * q + e] = gg[e]; } }
            if (t0 == 0) {
#pragma unroll
                for (int e = 0; e < 16; ++e) { cm2[e] = samp ? p.st_conv_a[((size_t)sq * 2 + 0) * 1024 + c0 + e] : 0.f; cm1[e] = samp ? p.st_conv_a[((size_t)sq * 2 + 1) * 1024 + c0 + e] : 0.f; }
            } else {
#pragma unroll
                for (int k = 0; k < 2; ++k) { const bf16_t* rp = PROJ + (size_t)(R0 - 2 + k) * 6144 + c0;
#pragma unroll
                    for (int q = 0; q < 2; ++q) { const u32x4 ah = *(const u32x4*)(rp + 8 * q), ac = *(const u32x4*)(rp + 1024 + 8 * q); float d[8];
                        d[0] = bflo(ah.x) * bflo(ac.x); d[1] = bfhi(ah.x) * bfhi(ac.x); d[2] = bflo(ah.y) * bflo(ac.y); d[3] = bfhi(ah.y) * bfhi(ac.y);
                        d[4] = bflo(ah.z) * bflo(ac.z); d[5] = bfhi(ah.z) * bfhi(ac.z); d[6] = bflo(ah.w) * bflo(ac.w); d[7] = bfhi(ah.w) * bfhi(ac.w);
#pragma unroll
                        for (int e = 0; e < 8; ++e) { if (k == 0) cm2[8 * q + e] = d[e]; else cm1[8 * q + e] = d[e]; } } }
            }
            u32x4 nx[6];
            { const bf16_t* rp = PROJ + (size_t)R0 * 6144 + c0;
#pragma unroll
              for (int q = 0; q < 2; ++q) { nx[3 * q] = *(const u32x4*)(rp + 8 * q); nx[3 * q + 1] = *(const u32x4*)(rp + 1024 + 8 * q); nx[3 * q + 2] = *(const u32x4*)(rp + 2048 + 8 * q); } }
#pragma unroll 1
            for (int r = 0; r < 8; ++r) {
                const int R = R0 + r, tt = t0 + r;
                u32x4 cu[6];
#pragma unroll
                for (int q = 0; q < 6; ++q) cu[q] = nx[q];
                if (r < 7) { const bf16_t* rp = PROJ + (size_t)(R + 1) * 6144 + c0;
#pragma unroll
                    for (int q = 0; q < 2; ++q) { nx[3 * q] = *(const u32x4*)(rp + 8 * q); nx[3 * q + 1] = *(const u32x4*)(rp + 1024 + 8 * q); nx[3 * q + 2] = *(const u32x4*)(rp + 2048 + 8 * q); } }
                float ca[16], v[16]; float ss = 0.f;
#pragma unroll
                for (int q = 0; q < 2; ++q) { const u32x4 ah = cu[3 * q], ac = cu[3 * q + 1], ab = cu[3 * q + 2]; float* d = ca + 8 * q; float bb[8];
                    d[0] = bflo(ah.x) * bflo(ac.x); d[1] = bfhi(ah.x) * bfhi(ac.x); d[2] = bflo(ah.y) * bflo(ac.y); d[3] = bfhi(ah.y) * bfhi(ac.y);
                    d[4] = bflo(ah.z) * bflo(ac.z); d[5] = bfhi(ah.z) * bfhi(ac.z); d[6] = bflo(ah.w) * bflo(ac.w); d[7] = bfhi(ah.w) * bfhi(ac.w);
                    bb[0] = bflo(ab.x); bb[1] = bfhi(ab.x); bb[2] = bflo(ab.y); bb[3] = bfhi(ab.y); bb[4] = bflo(ab.z); bb[5] = bfhi(ab.z); bb[6] = bflo(ab.w); bb[7] = bfhi(ab.w);
#pragma unroll
                    for (int e = 0; e < 8; ++e) { const float yv = wa2[8 * q + e] * d[e] + wa1[8 * q + e] * cm1[8 * q + e] + wa0[8 * q + e] * cm2[8 * q + e];
                        v[8 * q + e] = bb[e] * yv; ss += v[8 * q + e] * v[8 * q + e]; } }
                const float rn = rsqrtf(wave_sum(ss) * (1.f / 1024.f) + EPS);
                bf16_t* mrow = Bm + (size_t)mu_row(R) * DM + c0;
#pragma unroll
                for (int q = 0; q < 2; ++q) { float o[8];
#pragma unroll
                    for (int e = 0; e < 8; ++e) o[e] = v[8 * q + e] * rn * gna[8 * q + e];
                    u32x4 w; w.x = cvt_pk_bf16(o[0], o[1]); w.y = cvt_pk_bf16(o[2], o[3]); w.z = cvt_pk_bf16(o[4], o[5]); w.w = cvt_pk_bf16(o[6], o[7]);
                    *(u32x4*)(mrow + 8 * q) = w; }
                if (tt >= Tseq - 2) { float* d = out + (samp ? O_NCA_S : O_NCA_P) + ((size_t)sq * 2 + (tt - (Tseq - 2))) * 1024 + c0;
#pragma unroll
                    for (int e = 0; e < 16; ++e) d[e] = ca[e]; }
#pragma unroll
                for (int e = 0; e < 16; ++e) { cm2[e] = cm1[e]; cm1[e] = ca[e]; }
            }
        }
        for (int idx = gtid; idx < 12 * 3 * 3072; idx += NGT) {
            const int col = idx % 3072, r = (idx / 3072) % 3, sq = idx / 9216;
            if (sq < 4) out[O_NGC_P + ((size_t)sq * 3 + r) * 3072 + col] = bf2f(PROJ[(size_t)(sq * NPT + NPT - 3 + r) * 6144 + 3072 + col]);
            else out[O_NGC_S + ((size_t)(sq - 4) * 3 + r) * 3072 + col] = bf2f(PROJ[(size_t)(ROWS_P + (sq - 4) * 16 + 13 + r) * 6144 + 3072 + col]);
        }
    }
    xcd_barrier(xbar);

    PH(3) {
        PHASE_LOCALS
        const int fr = lane & 15, fq = lane >> 4;
        constexpr int RB = 59408;
        if (bx < 256) {
            const int x = bx & 7, y = bx >> 3, bh = x * 4 + (y >> 3), sl = y & 7, sidx = bh >> 3, h = bh & 7, item0 = bh * 65, dv0 = 16 * sl, rowbase = sidx * NPT;
            f32x4 S[8];
#pragma unroll
            for (int dt = 0; dt < 8; ++dt) S[dt] = (f32x4){0.f, 0.f, 0.f, 0.f};
            u32x4 stgA[12], stgB[12];
            const int lt = tid - 64;
#define P3_ISSUE(stg, eg, c) do { const unsigned char* bsrc = GDN + (size_t)(item0 + (c)) * BLOB; _Pragma("unroll") for (int k = 0; k < 12; ++k) { int i = lt + 320 * k; i = i > 3712 ? 3712 : i; \
                const int so = i < 3584 ? i * 16 : (i < 3712 ? 57344 + dv0 * 128 + (i - 3584) * 16 : 73728); stg[k] = *(const u32x4*)(bsrc + so); } } while (0)
#define P3_WRITE(stg, eg, c) do { LAS unsigned char* bdst = lds + ((c) & 1) * RB; _Pragma("unroll") for (int k = 0; k < 12; ++k) { int i = lt + 320 * k; i = i > 3712 ? 3712 : i; *(LAS u32x4*)(bdst + i * 16) = stg[k]; } } while (0)
#define P3_BAR() do { asm volatile("s_waitcnt lgkmcnt(0)" ::: "memory"); __builtin_amdgcn_s_barrier(); asm volatile("" ::: "memory"); } while (0)
#define P3_COMPUTE(c) do { const LAS bf16_t* Wl = (const LAS bf16_t*)(lds + ((c) & 1) * RB); \
                gdn_step_lds(S, Wl, Wl + 28672, *(const LAS float*)(Wl + 29696), OBUF + (size_t)rowbase * 1024 + h * 128 + dv0 + fr, 64 * (c) - 48, NPT, fr, fq); } while (0)
            if (wave == 0) {
                P3_BAR();
#pragma unroll 1
                for (int c = 0; c < 65; ++c) { P3_COMPUTE(c); P3_BAR(); }
            } else if (wave < 6) {
                P3_ISSUE(stgB, 0, 0); P3_ISSUE(stgA, 0, 1); P3_WRITE(stgB, 0, 0); P3_ISSUE(stgB, 0, 2);
                P3_BAR();
#pragma unroll 1
                for (int c = 0; c < 64; c += 2) {
                    P3_WRITE(stgA, 0, c + 1); if (c + 3 < 65) P3_ISSUE(stgA, 0, c + 3);
                    P3_BAR();
                    P3_WRITE(stgB, 0, c + 2); if (c + 4 < 65) P3_ISSUE(stgB, 0, c + 4);
                    P3_BAR();
                }
                P3_BAR();
            } else {
                constexpr int I_UP = 32 * 352, I_DN = 88 * 64;
                LAS float* scr = (LAS float*)(lds + 2 * RB + (wave - 6) * 8448);
                const int sw = bx * 2 + (wave - 6);
                float tr[32];
#define P3_TR_ISSUE(it) do { if ((it) < I_UP) { const int kb = (it) / 352, nb = (it) - kb * 352; transpose_issue(tr, p.w_up, 2 * DFF, 64 * kb, 32 * nb, lane); } \
                    else { const int r_ = (it) - I_UP, kb = r_ >> 6, nb = r_ & 63; transpose_issue(tr, p.w_down, DM, 64 * kb, 32 * nb, lane); } } while (0)
#define P3_TR_FINISH(it) do { if ((it) < I_UP) { const int kb = (it) / 352, nb = (it) - kb * 352, n0 = 32 * nb; const int j_ = n0 < DFF ? n0 : n0 - DFF; const int drow = 256 * (j_ >> 7) + (n0 < DFF ? 0 : 128) + (j_ & 127); \
                        transpose_finish(tr, Wt_up, DM, 64 * kb, drow, scr, lane); } \
                    else { const int r_ = (it) - I_UP, kb = r_ >> 6, nb = r_ & 63; transpose_finish(tr, Wt_down, DFF, 64 * kb, 32 * nb, scr, lane); } } while (0)
                int it = sw;
                if (it < I_UP + I_DN) P3_TR_ISSUE(it);
                P3_BAR();
#pragma unroll 1
                for (int c = 0; c < 65; ++c) {
                    if (it < I_UP + I_DN) { P3_TR_FINISH(it); it += 512; if (it < I_UP + I_DN) P3_TR_ISSUE(it); }
                    P3_BAR();
                }
#pragma unroll 1
                while (it < I_UP + I_DN) { P3_TR_FINISH(it); it += 512; if (it < I_UP + I_DN) P3_TR_ISSUE(it); }
            }
            if (wave == 0) {
                float* sd = out + O_NGD_P + ((size_t)sidx * 8 + h) * 16384;
#pragma unroll
                for (int dt = 0; dt < 8; ++dt)
#pragma unroll
                    for (int jj = 0; jj < 4; ++jj) sd[(16 * dt + 4 * fq + jj) * 128 + dv0 + fr] = S[dt][jj];
            }
        }
        if (wave < 2) {
            const int w = 2 * bx + wave;
            if (w < 512) {
                const int sh = w >> 3, sl = w & 7, sidx = sh >> 3, h = sh & 7, dv0 = 16 * sl, item = NITEM_P + sh;
                f32x4 S[8];
#pragma unroll
                for (int dt = 0; dt < 8; ++dt)
#pragma unroll
                    for (int jj = 0; jj < 4; ++jj) S[dt][jj] = p.st_gdn[(((size_t)sidx * 8 + h) * 128 + 16 * dt + 4 * fq + jj) * 128 + dv0 + fr];
                const bf16_t* Wg = (const bf16_t*)(GDN + (size_t)item * BLOB);
                gdn_step_glb(S, Wg, Wg + 28672 + dv0 * 64, EGL[item], OBUF + (size_t)(ROWS_P + sidx * 16) * 1024 + h * 128 + dv0 + fr, 0, 16, fr, fq);
                float* sd = out + O_NGD_S + ((size_t)sidx * 8 + h) * 16384;
#pragma unroll
                for (int dt = 0; dt < 8; ++dt)
#pragma unroll
                    for (int jj = 0; jj < 4; ++jj) sd[(16 * dt + 4 * fq + jj) * 128 + dv0 + fr] = S[dt][jj];
            }
        }
    }
    xcd_barrier(xbar);

    PH(4) {
        PHASE_LOCALS
        for (int R = gw; R < ROWS_V; R += NGW) {
            const int hh = lane >> 3, e0 = (lane & 7) * 16; const float* op = OBUF + (size_t)R * 1024 + hh * 128 + e0;
            f32x4 o[4]; float ss = 0.f;
#pragma unroll
            for (int q = 0; q < 4; ++q) { o[q] = *(const f32x4*)(op + 4 * q); ss += (o[q][0] * o[q][0] + o[q][1] * o[q][1]) + (o[q][2] * o[q][2] + o[q][3] * o[q][3]); }
            ss += __shfl_xor(ss, 1); ss += __shfl_xor(ss, 2); ss += __shfl_xor(ss, 4);
            const float rn = rsqrtf(ss * (1.f / 128.f) + EPS);
            const bf16_t* zp = Zb + (size_t)R * 1024 + hh * 128 + e0;
#pragma unroll
            for (int q = 0; q < 2; ++q) { const u32x4 zr = *(const u32x4*)(zp + 8 * q); float zz[8] = {bflo(zr.x), bfhi(zr.x), bflo(zr.y), bfhi(zr.y), bflo(zr.z), bfhi(zr.z), bflo(zr.w), bfhi(zr.w)}; float y[8];
#pragma unroll
                for (int e = 0; e < 8; ++e) y[e] = o[2 * q + (e >> 2)][e & 3] * rn * p.g_norm_gdn[e0 + 8 * q + e] * silu_f(zz[e]);
                u32x4 w; w.x = cvt_pk_bf16(y[0], y[1]); w.y = cvt_pk_bf16(y[2], y[3]); w.z = cvt_pk_bf16(y[4], y[5]); w.w = cvt_pk_bf16(y[6], y[7]);
                *(u32x4*)(Bm + (size_t)mu_row(R) * DM + 1024 + hh * 128 + e0 + 8 * q) = w; }
        }
    }
    xcd_barrier(xbar);

    PH(5) {
        PHASE_LOCALS
        pg8::Gemm g{Bm, Wt_out, DM, (size_t)256 * DM * 2}; pg8::PanelOrder S{bx};
        pg8::EpiMix E{X1, p.xp, p.g_post_mix, (float*)(ws + 512 * 1024), (unsigned*)ws + 12288, (LAS float*)(lds + pg8::STAGE_BYTES)};
        if (G == 256) pg8::gemm_phase<pg8::EpiMix, pg8::PanelOrder>(lds, g, S, E);
        const int fr = lane & 15, fq = lane >> 4;
        for (int job = bx; job < 12 * 32; job += G) {
            const int rt = job % 12, cgp = job / 12;
            const bf16_t* ap = Bm + (size_t)(16384 + 16 * rt + fr) * DM + 8 * fq + wave * 256;
            const bf16_t* bp = Wt_out + (size_t)(64 * cgp + fr) * DM + 8 * fq + wave * 256;
            f32x4 acc[4];
#pragma unroll
            for (int n = 0; n < 4; ++n) acc[n] = (f32x4){0.f, 0.f, 0.f, 0.f};
#pragma unroll 2
            for (int ks = 0; ks < 8; ++ks) { const bf16x8 a = *(const bf16x8*)(ap + 32 * ks);
#pragma unroll
                for (int n = 0; n < 4; ++n) { const bf16x8 b = *(const bf16x8*)(bp + (size_t)16 * n * DM + 32 * ks); acc[n] = __builtin_amdgcn_mfma_f32_16x16x32_bf16(b, a, acc[n], 0, 0, 0); } }
            LAS f32x4* red = (LAS f32x4*)lds;
            __syncthreads();
#pragma unroll
            for (int n = 0; n < 4; ++n) red[(wave * 4 + n) * 64 + lane] = acc[n];
            __syncthreads();
            if (wave == 0) {
                float ss = 0.f; const int q = 16384 + 16 * rt + fr;
#pragma unroll
                for (int n = 0; n < 4; ++n) { f32x4 v = red[n * 64 + lane];
#pragma unroll
                    for (int w2 = 1; w2 < 8; ++w2) v += red[(w2 * 4 + n) * 64 + lane];
                    ss += (v[0] * v[0] + v[1] * v[1]) + (v[2] * v[2] + v[3] * v[3]);
                    u32x2 w; w.x = cvt_pk_bf16(v[0], v[1]); w.y = cvt_pk_bf16(v[2], v[3]); *(u32x2*)(MOb + (size_t)q * DM + 64 * cgp + 16 * n + 4 * fq) = w; }
                ss += __shfl_xor(ss, 16); ss += __shfl_xor(ss, 32);
                if (fq == 0) PART[(size_t)q * 32 + cgp] = ss;
            }
        }
    }
    xcd_barrier(xbar);

    PH(6) {
        PHASE_LOCALS
        {
            u32x2 nx[8];
            { const int q = gw; const int R = (q >> 12) * NPT + 16 + (q & 4095);
#pragma unroll
              for (int j = 0; j < 8; ++j) nx[j] = *(const u32x2*)(X1 + (size_t)R * DM + 4 * lane + 256 * j); }
#pragma unroll 1
            for (int q = gw; q < 16384; q += NGW) {
                const int R = (q >> 12) * NPT + 16 + (q & 4095);
                f32x4 v[8];
#pragma unroll
                for (int j = 0; j < 8; ++j) v[j] = (f32x4){bflo(nx[j].x), bfhi(nx[j].x), bflo(nx[j].y), bfhi(nx[j].y)};
                const int qn = q + NGW;
                if (qn < 16384) { const int Rn = (qn >> 12) * NPT + 16 + (qn & 4095);
#pragma unroll
                    for (int j = 0; j < 8; ++j) nx[j] = *(const u32x2*)(X1 + (size_t)Rn * DM + 4 * lane + 256 * j); }
                norm_store_bf16(v, p.g_pre_ffn, Bm + (size_t)R * DM, lane);
            }
        }
        for (int k = gw; k < 64 + 128 + 2 + 192; k += NGW) {
            int R;
            if (k < 64) R = (k >> 4) * NPT + (k & 15); else if (k < 192) R = ROWS_P + (k - 64); else if (k < 194) R = k - 194; else R = ROWS_V + (k - 194);
            const float* xr = x_row(p, R); bf16_t* orow = Bm + (size_t)R * DM;
            if (xr) {
                const int mr = mu_row(R);
                float ps = (lane < 32) ? PART[(size_t)mr * 32 + lane] : 0.f; ps = wave_sum(ps);
                const float rn = rsqrtf(ps * (1.f / DM) + EPS);
                f32x4 v[8];
#pragma unroll
                for (int j = 0; j < 8; ++j) { const int c = 4 * lane + 256 * j; const f32x4 xv = *(const f32x4*)(xr + c), gg = *(const f32x4*)(p.g_post_mix + c); const u32x2 mr2 = *(const u32x2*)(MOb + (size_t)mr * DM + c);
                    const f32x4 mv = (f32x4){bflo(mr2.x), bfhi(mr2.x), bflo(mr2.y), bfhi(mr2.y)};
                    v[j] = xv + mv * rn * gg; u32x2 xw; xw.x = cvt_pk_bf16(v[j][0], v[j][1]); xw.y = cvt_pk_bf16(v[j][2], v[j][3]); *(u32x2*)(X1 + (size_t)R * DM + c) = xw; }
                norm_store_bf16(v, p.g_pre_ffn, orow, lane);
            } else {
#pragma unroll
                for (int j = 0; j < 8; ++j) *(u32x2*)(orow + 4 * lane + 256 * j) = (u32x2){0u, 0u};
            }
        }
    }
    xcd_barrier(xbar);

    PH(7) {
        PHASE_LOCALS
        pg8::Gemm g{Bm - 2 * DM, Wt_up, DM, (size_t)254 * DM * 2}; pg8::StaticOrder S; S.init(66, 44, G, bx);
        pg8::EpiGate E{Fb, p.w_conv_ffn, p.st_ffn_conv, out, (LAS float*)(lds + pg8::STAGE_BYTES)};
        pg8::gemm_phase<pg8::EpiGate>(lds, g, S, E);
    }
    xcd_barrier(xbar);

    PH(9) {
        PHASE_LOCALS
        pg8::Gemm g{Fb, Wt_down, DFF, (size_t)256 * DFF * 2}; pg8::PanelOrder S{bx};
        pg8::EpiFinal E{out + O_YP, X1, p.g_post_ffn, (float*)(ws + 512 * 1024), (unsigned*)ws + 8192, (LAS float*)(lds + pg8::STAGE_BYTES)};
        if (G == 256) pg8::gemm_phase<pg8::EpiFinal, pg8::PanelOrder>(lds, g, S, E);
        if (bx < 256) {
            const int fr = lane & 15, fq = lane >> 4, rt = bx & 7, cgp = bx >> 3;
            const bf16_t* ap = Fb + (size_t)(16384 + 16 * rt + fr) * DFF + 8 * fq + wave * 704;
            const bf16_t* bp = Wt_down + (size_t)(64 * cgp + fr) * DFF + 8 * fq + wave * 704;
            f32x4 acc[4];
#pragma unroll
            for (int n = 0; n < 4; ++n) acc[n] = (f32x4){0.f, 0.f, 0.f, 0.f};
#pragma unroll 2
            for (int ks = 0; ks < 22; ++ks) { const bf16x8 a = *(const bf16x8*)(ap + 32 * ks);
#pragma unroll
                for (int n = 0; n < 4; ++n) { const bf16x8 b = *(const bf16x8*)(bp + (size_t)16 * n * DFF + 32 * ks); acc[n] = __builtin_amdgcn_mfma_f32_16x16x32_bf16(b, a, acc[n], 0, 0, 0); } }
            LAS f32x4* red = (LAS f32x4*)lds;
#pragma unroll
            for (int n = 0; n < 4; ++n) red[(wave * 4 + n) * 64 + lane] = acc[n];
            __syncthreads();
            if (wave == 0) {
                float ss = 0.f; const int q = 16384 + 16 * rt + fr;
#pragma unroll
                for (int n = 0; n < 4; ++n) { f32x4 v = red[n * 64 + lane];
#pragma unroll
                    for (int w2 = 1; w2 < 8; ++w2) v += red[(w2 * 4 + n) * 64 + lane];
                    ss += (v[0] * v[0] + v[1] * v[1]) + (v[2] * v[2] + v[3] * v[3]);
                    u32x2 w; w.x = cvt_pk_bf16(v[0], v[1]); w.y = cvt_pk_bf16(v[2], v[3]); *(u32x2*)(FOb + (size_t)q * DM + 64 * cgp + 16 * n + 4 * fq) = w; }
                ss += __shfl_xor(ss, 16); ss += __shfl_xor(ss, 32);
                if (fq == 0) PART[(size_t)q * 32 + cgp] = ss;
            }
        }
    }
    xcd_barrier(xbar);

    PH(10) {
        PHASE_LOCALS
        for (int q = 16384 + gw; q < 16384 + 128; q += NGW) {
            int R; float* yrow;
            if (q < 16384) { const int b = q >> 12, t = q & 4095; R = b * NPT + 16 + t; yrow = out + O_YP + (size_t)q * DM; } else { R = ROWS_P + (q - 16384); yrow = out + O_YS + (size_t)(q - 16384) * DM; }
            float ps = (lane < 32) ? PART[(size_t)q * 32 + lane] : 0.f; ps = wave_sum(ps);
            const float rn = rsqrtf(ps * (1.f / DM) + EPS);
#pragma unroll
            for (int j = 0; j < 8; ++j) { const int c = 4 * lane + 256 * j; const f32x4 gg = *(const f32x4*)(p.g_post_ffn + c); const u32x2 fr2 = *(const u32x2*)(FOb + (size_t)q * DM + c); const f32x4 fv = (f32x4){bflo(fr2.x), bfhi(fr2.x), bflo(fr2.y), bfhi(fr2.y)}; const u32x2 xr2 = *(const u32x2*)(X1 + (size_t)R * DM + c); const f32x4 xv = (f32x4){bflo(xr2.x), bfhi(xr2.x), bflo(xr2.y), bfhi(xr2.y)};
                *(f32x4*)(yrow + c) = xv + fv * rn * gg; }
        }
    }
}

extern "C" void kernel_launch(void* const* d_in, const int* in_sizes, int n_in, void* d_out, int out_size, void* d_ws, size_t ws_size, hipStream_t stream) {
    static int grid = 0;
    if (grid == 0) {
        if (n_in != 22 || (size_t)out_size != O_END || ws_size < WS_END) { fprintf(stderr, "kernel_launch: unexpected shapes: n_in %d out %d ws %zu\n", n_in, out_size, ws_size); grid = -1; return; }
        int dev = 0, cus = 0, per_cu = 0;
        hipGetDevice(&dev); hipDeviceGetAttribute(&cus, hipDeviceAttributeMultiprocessorCount, dev);
        hipFuncSetAttribute((const void*)hymba_fwd, hipFuncAttributeMaxDynamicSharedMemorySize, LDS_BYTES);
        hipOccupancyMaxActiveBlocksPerMultiprocessor(&per_cu, (const void*)hymba_fwd, 512, LDS_BYTES);
        if (per_cu < 1) { fprintf(stderr, "kernel_launch: occupancy query says %d blocks per CU\n", per_cu); per_cu = 1; }
        grid = cus;
        (void)hipGetLastError();
    }
    if (grid < 0) return;
    (void)hipMemsetAsync(d_ws, 0, 65536, stream);
    Params p{};
    const float** pp = (const float**)&p;
    for (int i = 0; i < 22; ++i) pp[i] = (const float*)d_in[i];
    p.out = (float*)d_out; p.ws = (unsigned char*)d_ws;
    void* args[] = {&p};
    hipError_t e = hipLaunchCooperativeKernel((const void*)hymba_fwd, dim3(grid), dim3(512), args, LDS_BYTES, stream);
    if (e != hipSuccess) fprintf(stderr, "cooperative launch failed: %s (grid %d)\n", hipGetErrorString(e), grid);
}
```

```cpp
#include <hip/hip_runtime.h>
#include <hip/hip_cooperative_groups.h>
#include <cstdio>
#include <cstdint>
namespace cg = cooperative_groups;

#define LAS __attribute__((address_space(3)))
typedef unsigned short bf16_t;
typedef short bf16x8 __attribute__((ext_vector_type(8)));
typedef float f32x4 __attribute__((ext_vector_type(4)));
typedef unsigned u32x4 __attribute__((ext_vector_type(4)));
typedef unsigned u32x2 __attribute__((ext_vector_type(2)));

constexpr int DM = 2048, NPT = 4112  , ROWS_P = 4 * NPT  , ROWS_V = ROWS_P + 128  , T_PAD = 16640;
constexpr int DFF = 5632, INC = 7184;
constexpr int NITEM_P = 4 * 8 * 65, NITEM = NITEM_P + 64;
constexpr float EPS = 1e-6f;
constexpr size_t O_YP = 0, O_YS = 33554432, O_NCA_P = 33816576, O_NGC_P = 33824768, O_NGD_P = 33861632, O_NFC_P = 34385920,
                 O_NCA_S = 34430976, O_NGC_S = 34447360, O_NGD_S = 34521088, O_NFC_S = 35569664, O_END = 35659776;
constexpr size_t MiB = 1u << 20;
constexpr size_t WS_PART = 1 * MiB;
constexpr size_t WS_EGL = 3 * MiB + 512 * 1024;
constexpr size_t WS_WIN = 4 * MiB;
constexpr size_t WS_WDOWN = 4 * MiB;
constexpr size_t WS_WOUT = 33 * MiB;
constexpr size_t WS_B = 41 * MiB;
constexpr size_t WS_C = 107 * MiB;
constexpr size_t WS_Z = 302 * MiB;
constexpr size_t WS_AB = 334 * MiB + 768 * 1024;
constexpr size_t WS_GDN = 336 * MiB;
constexpr size_t WS_X1 = 445 * MiB;
constexpr size_t WS_WUP = 172 * MiB;
constexpr size_t WS_F = 216 * MiB;
constexpr size_t WS_END = 510 * MiB;
constexpr size_t BLOB = 73984;
static_assert(WS_Z + (size_t)T_PAD * 2048 <= WS_AB && WS_AB + (size_t)T_PAD * 64 <= WS_GDN && WS_GDN + (size_t)NITEM * BLOB <= 488 * MiB && WS_PART + (size_t)T_PAD * 128 <= WS_EGL, "ws map");
constexpr int LDS_BYTES = 147456;
#ifndef PHASE_MASK
#define PHASE_MASK 0xFFFF
#endif
#ifndef P2MASK
#define P2MASK 0xFF
#endif
#define P2(n) if constexpr (((P2MASK) >> (n)) & 1)
#ifndef REPEAT_MASK
#define REPEAT_MASK 0
#endif
#ifndef EXTRA_SYNCS
#define EXTRA_SYNCS 0
#endif
#define PH(n) if constexpr (((PHASE_MASK) >> (n)) & 1)

__device__ __forceinline__ unsigned cvt_pk_bf16(float lo, float hi) { unsigned r; asm volatile("v_cvt_pk_bf16_f32 %0, %1, %2" : "=v"(r) : "v"(lo), "v"(hi)); return r; }
__device__ __forceinline__ unsigned short f2bf(float f) { return (unsigned short)(cvt_pk_bf16(f, 0.f) & 0xffffu); }
__device__ __forceinline__ float bf2f(unsigned short b) { return __uint_as_float((unsigned)b << 16); }
__device__ __forceinline__ float bflo(unsigned w) { return __uint_as_float(w << 16); }
__device__ __forceinline__ float bfhi(unsigned w) { return __uint_as_float(w & 0xffff0000u); }
__device__ __forceinline__ float wave_sum(float v) {
#pragma unroll
    for (int o = 1; o < 64; o <<= 1) v += __shfl_xor(v, o);
    return v;
}
__device__ __forceinline__ float silu_f(float x) { return x * __builtin_amdgcn_rcpf(1.f + __expf(-x)); }
__device__ __forceinline__ int perm32(int k) { return ((k >> 2) & 3) * 8 + ((k >> 4) & 1) * 4 + (k & 3); }
#define LDS_WAIT() asm volatile("s_waitcnt lgkmcnt(0)" ::: "memory")

struct Params {
    const float *xp, *xs, *st_conv_a, *st_gdn_conv, *st_gdn, *st_ffn_conv, *meta, *g_pre_mix, *w_in, *w_conv_a, *g_norm_a, *w_conv_gdn,
                *a_log, *dt_bias, *g_norm_gdn, *w_out, *g_post_mix, *g_pre_ffn, *w_up, *w_conv_ffn, *w_down, *g_post_ffn;
    float* out; unsigned char* ws;
};
__device__ __forceinline__ const float* x_row(const Params& p, int R) {
    if (R < 0) return nullptr;
    if (R < ROWS_P) { const int b = R / NPT, t = R - b * NPT; return t < 16 ? p.meta + (size_t)t * DM : p.xp + ((size_t)b * 4096 + (t - 16)) * DM; }
    if (R < ROWS_V) return p.xs + (size_t)(R - ROWS_P) * DM;
    return nullptr;
}

__device__ __forceinline__ int mu_row(int R) {
    if (R < ROWS_P) { const int b = R / NPT, t = R - b * NPT; return t >= 16 ? b * 4096 + (t - 16) : 16512 + b * 16 + t; }
    return 16384 + (R - ROWS_P);
}

namespace pg8 {
constexpr int BM = 256, BK = 64, HALF = 128, HTB = HALF * BK * 2, STAGE_BYTES = 8 * HTB, NXCD = 8, WGM = 8;
__host__ __device__ __forceinline__ int lds_byte(int r, int c) { const int st = (r >> 4) * 2 + (c >> 5), rr = r & 15, cc = c & 31, ob = rr * 64 + cc * 2; return st * 1024 + (ob ^ (((ob >> 9) & 1) << 5)); }
__host__ __device__ __forceinline__ void stage_rc(int b, int& R, int& C) { const int st = b / 1024, sb = b % 1024, swz = sb ^ (((sb >> 9) & 1) << 5); R = (st >> 1) * 16 + swz / 64; C = (st & 1) * 32 + (swz % 64) / 2; }
__host__ __device__ __forceinline__ int permB(int rho) { const int n = rho >> 4, i = rho & 15; return 8 * (i >> 2) + 4 * n + (i & 3); }
struct Unit { int pm, pn; };
struct Gemm { const bf16_t* A; const bf16_t* Bt; int K; size_t a_tstep; };
struct StaticOrder {
    int nM, nN, nwg, G, c;
    __device__ void init(int nM_, int nN_, int G_, int c_) { nM = nM_; nN = nN_; nwg = nM * nN; G = G_; c = c_; }
    __device__ bool next(int i, Unit& u) const {
        const long L = (long)i * G + c; if (L >= nwg) return false;
        int wgid = (int)L; { const int q = nwg / NXCD, r = nwg % NXCD, xcd = wgid % NXCD, off = wgid / NXCD; wgid = (xcd < r ? xcd * (q + 1) : r * (q + 1) + (xcd - r) * q) + off; }
        const int nig = WGM * nN, gid = wgid / nig, fm = gid * WGM, gsz = (nM - fm) < WGM ? (nM - fm) : WGM;
        u.pm = fm + ((wgid % nig) % gsz); u.pn = (wgid % nig) / gsz; return true;
    }
};
struct PanelOrder {
    int c;
    __device__ bool next(int i, Unit& u) const { if (i >= 2) return false; const int x = c & 7, j = c >> 3; u.pm = 32 * i + 4 * x + (j >> 3); u.pn = j & 7; return true; }
};
template <class Epi, class Sched = StaticOrder>
__device__ __forceinline__ void gemm_phase(LAS unsigned char* lds, const Gemm g, const Sched& S, const Epi& E) {
    int tid_ = threadIdx.x; asm volatile("" : "+v"(tid_));
    const int tid = tid_, wid = __builtin_amdgcn_readfirstlane(tid >> 6), lane = tid & 63, wr = wid >> 2, wc = wid & 3, fr = lane & 15, fq = lane >> 4;
    const int K = g.K, nt = K / BK;
    unsigned voffA[2], voffB[2];
#pragma unroll
    for (int i = 0; i < 2; ++i) { int R, C; stage_rc(tid * 16 + i * 8192, R, C); const int Rb = Epi::PERM ? ((R & ~31) + permB(R & 31)) : R;
        voffA[i] = (unsigned)(R * K + C) * 2u; voffB[i] = (unsigned)(Rb * K + C) * 2u; }
    const size_t kstep = (size_t)(BK * 2);
    const size_t hstep = (size_t)HALF * K * 2;
    const size_t tstepB = 2 * hstep, tstepA = g.a_tstep;
    const unsigned ldsw = (unsigned)wid * 1024u;
    const int aoff = lds_byte(wr * 64 + fr, fq * 8), boff = lds_byte(wc * 32 + fr, fq * 8);
#define PG8_SA(b, h) (((b) * 2 + (h)) * HTB)
#define PG8_SB(b, h) ((4 + (b) * 2 + (h)) * HTB)
#define PG8_STAGE(bufoff, gbase, voff) do { _Pragma("unroll") for (int _i = 0; _i < 2; ++_i) \
        __builtin_amdgcn_global_load_lds((const unsigned*)((const char*)(gbase) + (voff)[_i]), (LAS unsigned*)(lds + (bufoff) + ldsw + _i * 8192), 16, 0, 0); } while (0)
#define PG8_LDA(dst, b, h) do { _Pragma("unroll") for (int m = 0; m < 4; ++m) _Pragma("unroll") for (int k = 0; k < 2; ++k) dst[m][k] = *(const LAS bf16x8*)(lds + PG8_SA(b, h) + aoff + m * 2048 + k * 1024); } while (0)
#define PG8_LDB(dst, b, h) do { _Pragma("unroll") for (int n = 0; n < 2; ++n) _Pragma("unroll") for (int k = 0; k < 2; ++k) dst[n][k] = *(const LAS bf16x8*)(lds + PG8_SB(b, h) + boff + n * 2048 + k * 1024); } while (0)
#define PG8_MMA(ai, bj, At, Bt) do { __builtin_amdgcn_s_setprio(1); _Pragma("unroll") for (int m = 0; m < 4; ++m) _Pragma("unroll") for (int n = 0; n < 2; ++n) _Pragma("unroll") for (int k = 0; k < 2; ++k) \
        acc[ai][bj][m][n] = __builtin_amdgcn_mfma_f32_16x16x32_bf16(Bt[n][k], At[m][k], acc[ai][bj][m][n], 0, 0, 0); __builtin_amdgcn_s_setprio(0); } while (0)
#define PG8_WAIT_V(n) asm volatile("s_waitcnt vmcnt(" #n ")" ::: "memory")
#define PG8_WAIT_L(n) asm volatile("s_waitcnt lgkmcnt(" #n ")" ::: "memory")
#define PG8_BAR __builtin_amdgcn_s_barrier()
#define PG8_SCHED __builtin_amdgcn_sched_barrier(0)
    Unit cur, nxt; int ui = 0;
    if (!S.next(0, cur)) return;
    f32x4 acc[2][2][4][2];
#pragma unroll
    for (int a = 0; a < 2; ++a)
#pragma unroll
        for (int b = 0; b < 2; ++b)
#pragma unroll
            for (int m = 0; m < 4; ++m)
#pragma unroll
                for (int n = 0; n < 2; ++n) acc[a][b][m][n] = (f32x4){0.f, 0.f, 0.f, 0.f};
    bf16x8 At[4][2], B0[2][2], B1[2][2];
    const char* cA = (const char*)g.A + (size_t)cur.pm * tstepA; const char* cB = (const char*)g.Bt + (size_t)cur.pn * tstepB;
    PG8_STAGE(PG8_SB(0, 0), cB, voffB); PG8_STAGE(PG8_SB(0, 1), cB + hstep, voffB); PG8_STAGE(PG8_SA(0, 0), cA, voffA); PG8_STAGE(PG8_SA(0, 1), cA + hstep, voffA);
    if (wr == 1) PG8_BAR;
    PG8_WAIT_V(2); PG8_BAR;
    PG8_STAGE(PG8_SB(1, 0), cB + kstep, voffB); PG8_STAGE(PG8_SA(1, 0), cA + kstep, voffA); PG8_STAGE(PG8_SB(1, 1), cB + hstep + kstep, voffB);
    PG8_WAIT_V(6); PG8_BAR;
    for (;;) {
        const bool has_next = S.next(ui + 1, nxt);
        const char* nA = has_next ? (const char*)g.A + (size_t)nxt.pm * tstepA : cA; const char* nB = has_next ? (const char*)g.Bt + (size_t)nxt.pn * tstepB : cB;
        for (int t = 0; t < nt; t += 2) {
            const bool last = (t == nt - 2);
            const char* a1 = cA + (size_t)(t + 1) * kstep;
            const char* a2 = last ? nA : cA + (size_t)(t + 2) * kstep; const char* b2 = last ? nB : cB + (size_t)(t + 2) * kstep;
            const char* a3 = a2 + kstep; const char* b3 = b2 + kstep;
            PG8_LDB(B0, 0, 0); PG8_LDB(B1, 0, 1); PG8_SCHED; PG8_LDA(At, 0, 0); PG8_STAGE(PG8_SA(1, 1), a1 + hstep, voffA);
            PG8_WAIT_V(8); PG8_WAIT_L(0); PG8_BAR; PG8_MMA(0, 0, At, B0); PG8_MMA(0, 1, At, B1); PG8_BAR; PG8_SCHED;
            PG8_LDA(At, 0, 1); PG8_STAGE(PG8_SB(0, 0), b2, voffB); PG8_STAGE(PG8_SB(0, 1), b2 + hstep, voffB); PG8_STAGE(PG8_SA(0, 0), a2, voffA);
            PG8_WAIT_V(8); PG8_WAIT_L(0); PG8_BAR; PG8_MMA(1, 0, At, B0); PG8_MMA(1, 1, At, B1); PG8_BAR; PG8_SCHED;
            PG8_LDB(B0, 1, 0); PG8_LDB(B1, 1, 1); PG8_SCHED; PG8_LDA(At, 1, 0); PG8_STAGE(PG8_SA(0, 1), a2 + hstep, voffA);
            PG8_WAIT_V(8); PG8_WAIT_L(0); PG8_BAR; PG8_MMA(0, 0, At, B0); PG8_MMA(0, 1, At, B1); PG8_BAR; PG8_SCHED;
            PG8_LDA(At, 1, 1); PG8_STAGE(PG8_SB(1, 0), b3, voffB); PG8_STAGE(PG8_SB(1, 1), b3 + hstep, voffB); PG8_STAGE(PG8_SA(1, 0), a3, voffA);
            PG8_WAIT_V(8); PG8_WAIT_L(0); PG8_BAR; PG8_MMA(1, 0, At, B0); PG8_MMA(1, 1, At, B1); PG8_BAR; PG8_SCHED;
        }
        if (wr == 0) PG8_BAR;
        E(acc, cur, wr, wc, fr, fq);
        if (!has_next) break;
#pragma unroll
        for (int a = 0; a < 2; ++a)
#pragma unroll
            for (int b = 0; b < 2; ++b)
#pragma unroll
                for (int m = 0; m < 4; ++m)
#pragma unroll
                    for (int n = 0; n < 2; ++n) acc[a][b][m][n] = (f32x4){0.f, 0.f, 0.f, 0.f};
        cur = nxt; cA = nA; cB = nB; ++ui;
        if (wr == 1) PG8_BAR;
    }
    PG8_WAIT_V(0);
    PG8_BAR;
#undef PG8_SA
#undef PG8_SB
#undef PG8_STAGE
#undef PG8_LDA
#undef PG8_LDB
#undef PG8_MMA
#undef PG8_WAIT_V
#undef PG8_WAIT_L
#undef PG8_BAR
#undef PG8_SCHED
}

struct EpiProj {
    static constexpr bool PERM = true;
    bf16_t* proj; bf16_t* z; float* ab;
    __device__ __forceinline__ void operator()(const f32x4 (&acc)[2][2][4][2], const Unit& u, int wr, int wc, int fr, int fq) const {
        const int row0 = u.pm * BM + wr * 64 + fr;
        if (u.pn < 28) {
            bf16_t* base; int ldc;
            if (u.pn < 24) { base = proj + u.pn * 256 + wc * 32 + 8 * fq; ldc = 6144; } else { base = z + (u.pn - 24) * 256 + wc * 32 + 8 * fq; ldc = 1024; }
#pragma unroll
            for (int ai = 0; ai < 2; ++ai)
#pragma unroll
                for (int m = 0; m < 4; ++m) { bf16_t* rowp = base + (size_t)(row0 + ai * HALF + m * 16) * ldc;
#pragma unroll
                    for (int bj = 0; bj < 2; ++bj) { const f32x4 v0 = acc[ai][bj][m][0], v1 = acc[ai][bj][m][1];
                        u32x4 w; w.x = cvt_pk_bf16(v0[0], v0[1]); w.y = cvt_pk_bf16(v0[2], v0[3]); w.z = cvt_pk_bf16(v1[0], v1[1]); w.w = cvt_pk_bf16(v1[2], v1[3]);
                        *(u32x4*)(rowp + bj * HALF) = w; } }
        } else if (wc == 0 && fq < 2) {
#pragma unroll
            for (int ai = 0; ai < 2; ++ai)
#pragma unroll
                for (int m = 0; m < 4; ++m) { float* rowp = ab + (size_t)(row0 + ai * HALF + m * 16) * 16 + 8 * fq;
                    *(f32x4*)(rowp) = acc[ai][0][m][0]; *(f32x4*)(rowp + 4) = acc[ai][0][m][1]; }
        }
    }
};
struct EpiBf16Part {
    static constexpr bool PERM = false;
    bf16_t* outb; float* part;
    __device__ __forceinline__ void operator()(const f32x4 (&acc)[2][2][4][2], const Unit& u, int wr, int wc, int fr, int fq) const {
#pragma unroll
        for (int ai = 0; ai < 2; ++ai)
#pragma unroll
            for (int m = 0; m < 4; ++m) {
                const int r = u.pm * BM + ai * HALF + wr * 64 + m * 16 + fr;
                bf16_t* rowp = outb + (size_t)r * DM + u.pn * BM + wc * 32 + 4 * fq;
                float ss = 0.f;
#pragma unroll
                for (int bj = 0; bj < 2; ++bj)
#pragma unroll
                    for (int n = 0; n < 2; ++n) { const f32x4 v = acc[ai][bj][m][n]; ss += (v[0] * v[0] + v[1] * v[1]) + (v[2] * v[2] + v[3] * v[3]);
                        u32x2 w; w.x = cvt_pk_bf16(v[0], v[1]); w.y = cvt_pk_bf16(v[2], v[3]); *(u32x2*)(rowp + bj * HALF + n * 16) = w; }
                ss += __shfl_xor(ss, 16); ss += __shfl_xor(ss, 32);
                if (fq == 0) part[(size_t)r * 32 + u.pn * 4 + wc] = ss;
            }
    }
};
struct EpiFinal {
    static constexpr bool PERM = false;
    float* yout; const bf16_t* x1; const float* g; float* xbuf; unsigned* cnt; LAS float* ex;
    __device__ __forceinline__ void operator()(const f32x4 (&acc)[2][2][4][2], const Unit& u, int wr, int wc, int fr, int fq) const {
        const int tid = threadIdx.x;
        LAS float* P = ex; LAS float* RN = ex + 1024; LAS unsigned* flag = (LAS unsigned*)(ex + 1280);
#pragma unroll
        for (int ai = 0; ai < 2; ++ai)
#pragma unroll
            for (int m = 0; m < 4; ++m) { float ss = 0.f;
#pragma unroll
                for (int bj = 0; bj < 2; ++bj)
#pragma unroll
                    for (int n = 0; n < 2; ++n) { const f32x4 v = acc[ai][bj][m][n]; ss += (v[0] * v[0] + v[1] * v[1]) + (v[2] * v[2] + v[3] * v[3]); }
                ss += __shfl_xor(ss, 16); ss += __shfl_xor(ss, 32);
                if (fq == 0) P[(ai * HALF + wr * 64 + m * 16 + fr) * 4 + wc] = ss; }
        asm volatile("s_waitcnt lgkmcnt(0)" ::: "memory"); __builtin_amdgcn_s_barrier(); asm volatile("" ::: "memory");
        if (tid < 256) { const f32x4 pv = *(const LAS f32x4*)(P + tid * 4);
            __hip_atomic_store(xbuf + (size_t)(u.pm * 8 + u.pn) * 256 + tid, (pv[0] + pv[1]) + (pv[2] + pv[3]), __ATOMIC_RELAXED, __HIP_MEMORY_SCOPE_AGENT); }
        asm volatile("s_waitcnt vmcnt(0)" ::: "memory"); __builtin_amdgcn_s_barrier(); asm volatile("" ::: "memory");
        if (tid == 0) {
            __builtin_amdgcn_fence(__ATOMIC_RELEASE, "agent");
            __hip_atomic_fetch_add(cnt + 64 * u.pm, 1u, __ATOMIC_RELAXED, __HIP_MEMORY_SCOPE_AGENT);
            unsigned sp = 0u; while (__hip_atomic_load(cnt + 64 * u.pm, __ATOMIC_RELAXED, __HIP_MEMORY_SCOPE_AGENT) < 8u && sp < (1u << 24)) { __builtin_amdgcn_s_sleep(1); ++sp; }
            __builtin_amdgcn_fence(__ATOMIC_ACQUIRE, "agent");
            flag[0] = 1u;
        }
        asm volatile("s_waitcnt vmcnt(0) lgkmcnt(0)" ::: "memory"); __builtin_amdgcn_s_barrier(); asm volatile("" ::: "memory");
        if (tid < 256) { float tot = 0.f;
#pragma unroll
            for (int t8 = 0; t8 < 8; ++t8) tot += __hip_atomic_load(xbuf + (size_t)(u.pm * 8 + t8) * 256 + tid, __ATOMIC_RELAXED, __HIP_MEMORY_SCOPE_AGENT);
            RN[tid] = rsqrtf(tot * (1.f / DM) + EPS); }
        asm volatile("s_waitcnt vmcnt(0) lgkmcnt(0)" ::: "memory"); __builtin_amdgcn_s_barrier(); asm volatile("" ::: "memory");
        const int col0 = u.pn * BM + wc * 32 + 4 * fq;
#pragma unroll
        for (int ai = 0; ai < 2; ++ai)
#pragma unroll
            for (int m = 0; m < 4; ++m) {
                const int rl = ai * HALF + wr * 64 + m * 16 + fr, q = u.pm * BM + rl; const float rn = RN[rl];
                const int R = (q >> 12) * NPT + 16 + (q & 4095);
                const bf16_t* xp = x1 + (size_t)R * DM + col0; float* yp = yout + (size_t)q * DM + col0;
#pragma unroll
                for (int bj = 0; bj < 2; ++bj)
#pragma unroll
                    for (int n = 0; n < 2; ++n) { const int co = bj * HALF + n * 16; const u32x2 xr2 = *(const u32x2*)(xp + co); const f32x4 gg = *(const f32x4*)(g + col0 + co);
                        const f32x4 xv = (f32x4){bflo(xr2.x), bfhi(xr2.x), bflo(xr2.y), bfhi(xr2.y)};
                        *(f32x4*)(yp + co) = xv + acc[ai][bj][m][n] * rn * gg; }
            }
    }
};
struct EpiGate {
    static constexpr bool PERM = true;
    bf16_t* F; const float* wcf; const float* st_ffn; float* outb; LAS float* exch;
    __device__ __forceinline__ void operator()(const f32x4 (&acc)[2][2][4][2], const Unit& u, int wr, int wc, int fr, int fq) const {
        const int lane = fr + 16 * fq;
        if (fr >= 14) {
#pragma unroll
            for (int ai = 0; ai < 2; ++ai)
#pragma unroll
                for (int n = 0; n < 2; ++n) *(LAS f32x4*)(exch + (((((ai * 2 + wr) * 4 + wc) * 2 + (fr - 14)) * 2 + n) * 16) + fq * 4) = acc[ai][0][3][n];
        }
        asm volatile("s_waitcnt lgkmcnt(0)" ::: "memory"); __builtin_amdgcn_s_barrier(); asm volatile("" ::: "memory");
        const int j0 = u.pn * 128 + wc * 32 + 8 * fq;
        f32x4 w0[2], w1[2], w2[2];
#pragma unroll
        for (int n = 0; n < 2; ++n) { w0[n] = *(const f32x4*)(wcf + j0 + 4 * n); w1[n] = *(const f32x4*)(wcf + DFF + j0 + 4 * n); w2[n] = *(const f32x4*)(wcf + 2 * DFF + j0 + 4 * n); }
        const int src1 = (lane & 48) | ((fr - 1) & 15), src2 = (lane & 48) | ((fr - 2) & 15);
#pragma unroll
        for (int ai = 0; ai < 2; ++ai) {
            const int sl = 2 * ai + wr;
            f32x4 gprev[2];
#pragma unroll
            for (int n = 0; n < 2; ++n) { gprev[n] = (f32x4){0.f, 0.f, 0.f, 0.f};
                if (sl > 0 && fr >= 14) gprev[n] = *(const LAS f32x4*)(exch + ((((sl - 1) * 4 + wc) * 2 + (fr - 14)) * 2 + n) * 16 + fq * 4); }
#pragma unroll
            for (int m = 0; m < 4; ++m) {
                const int lr = ai * HALF + wr * 64 + m * 16 + fr, R = u.pm * 254 - 2 + lr;
                int t, Tseq, sq; bool samp = false;
                if (R < ROWS_P) { sq = R / NPT; t = R - sq * NPT; Tseq = NPT; if (R < 0) { sq = 0; t = 100; } }
                else { samp = true; sq = (R - ROWS_P) >> 4; t = (R - ROWS_P) & 15; Tseq = 16; }
                const bool valid = (lr >= 2) && (R < ROWS_V);
                u32x4 pk;
#pragma unroll
                for (int n = 0; n < 2; ++n) {
                    const f32x4 cur = acc[ai][0][m][n]; const f32x4 pm = (m == 0) ? gprev[n] : acc[ai][0][m == 0 ? 0 : m - 1][n];
                    f32x4 p1, p2;
#pragma unroll
                    for (int i = 0; i < 4; ++i) { const float r1 = (fr == 15) ? pm[i] : cur[i], r2 = (fr >= 14) ? pm[i] : cur[i]; p1[i] = __shfl(r1, src1); p2[i] = __shfl(r2, src2); }
                    if (valid && t < 2) {
                        f32x4 h0 = (f32x4){0.f, 0.f, 0.f, 0.f}, h1 = h0;
                        if (samp) { h0 = *(const f32x4*)(st_ffn + ((size_t)sq * 2 + 0) * DFF + j0 + 4 * n); h1 = *(const f32x4*)(st_ffn + ((size_t)sq * 2 + 1) * DFF + j0 + 4 * n); }
                        if (t == 0) { p1 = h1; p2 = h0; } else { p2 = h1; }
                    }
                    const f32x4 gc = w0[n] * p2 + w1[n] * p1 + w2[n] * cur; const f32x4 vv = acc[ai][1][m][n];
                    const float f0 = silu_f(gc[0]) * vv[0], f1 = silu_f(gc[1]) * vv[1], f2 = silu_f(gc[2]) * vv[2], f3 = silu_f(gc[3]) * vv[3];
                    if (n == 0) { pk.x = cvt_pk_bf16(f0, f1); pk.y = cvt_pk_bf16(f2, f3); } else { pk.z = cvt_pk_bf16(f0, f1); pk.w = cvt_pk_bf16(f2, f3); }
                    if (valid && t >= Tseq - 2) { float* d = outb + (samp ? O_NFC_S : O_NFC_P) + ((size_t)sq * 2 + (t - (Tseq - 2))) * DFF + j0 + 4 * n; *(f32x4*)d = cur; }
                }
                if (valid && (samp || t >= 16)) { const int frow = samp ? 16384 + (R - ROWS_P) : sq * 4096 + (t - 16); *(u32x4*)(F + (size_t)frow * DFF + j0) = pk; }
            }
        }
    }
};
}

__device__ __forceinline__ void transpose_item(const float* W, int ldw, int k0, int n0, bf16_t* WT, int K, int drow0, LAS float* scr, int lane) {
#pragma unroll 8
    for (int i = 0; i < 32; ++i) { const int kk = 2 * i + (lane >> 5); scr[kk * 33 + (lane & 31)] = W[(size_t)(k0 + kk) * ldw + n0 + (lane & 31)]; }
    LDS_WAIT();
    const int c = lane & 7;
#pragma unroll
    for (int j = 0; j < 4; ++j) { const int n = (lane >> 3) + 8 * j; const LAS float* s = scr + (8 * c) * 33 + n;
        u32x4 o; o.x = cvt_pk_bf16(s[0 * 33], s[1 * 33]); o.y = cvt_pk_bf16(s[2 * 33], s[3 * 33]); o.z = cvt_pk_bf16(s[4 * 33], s[5 * 33]); o.w = cvt_pk_bf16(s[6 * 33], s[7 * 33]);
        *(u32x4*)(WT + (size_t)(drow0 + n) * K + k0 + 8 * c) = o; }
    LDS_WAIT();
}
__device__ __forceinline__ void transpose_issue(float (&r)[32], const float* W, int ldw, int k0, int n0, int lane) {
#pragma unroll
    for (int i = 0; i < 32; ++i) { const int kk = 2 * i + (lane >> 5); r[i] = W[(size_t)(k0 + kk) * ldw + n0 + (lane & 31)]; }
}
__device__ __forceinline__ void transpose_finish(const float (&r)[32], bf16_t* WT, int K, int k0, int drow0, LAS float* scr, int lane) {
#pragma unroll
    for (int i = 0; i < 32; ++i) { const int kk = 2 * i + (lane >> 5); scr[kk * 33 + (lane & 31)] = r[i]; }
    LDS_WAIT();
    const int c = lane & 7;
#pragma unroll
    for (int j = 0; j < 4; ++j) { const int n = (lane >> 3) + 8 * j; const LAS float* s = scr + (8 * c) * 33 + n;
        u32x4 o; o.x = cvt_pk_bf16(s[0 * 33], s[1 * 33]); o.y = cvt_pk_bf16(s[2 * 33], s[3 * 33]); o.z = cvt_pk_bf16(s[4 * 33], s[5 * 33]); o.w = cvt_pk_bf16(s[6 * 33], s[7 * 33]);
        *(u32x4*)(WT + (size_t)(drow0 + n) * K + k0 + 8 * c) = o; }
    LDS_WAIT();
}
__device__ __forceinline__ void norm_store_bf16(const f32x4 (&v)[8], const float* g, bf16_t* orow, int lane) {
    float s = 0.f;
#pragma unroll
    for (int j = 0; j < 8; ++j) s += (v[j][0] * v[j][0] + v[j][1] * v[j][1]) + (v[j][2] * v[j][2] + v[j][3] * v[j][3]);
    const float r = rsqrtf(wave_sum(s) * (1.f / DM) + EPS);
#pragma unroll
    for (int j = 0; j < 8; ++j) { const f32x4 gg = *(const f32x4*)(g + 4 * lane + 256 * j); const f32x4 o = v[j] * r * gg;
        u32x2 w; w.x = cvt_pk_bf16(o[0], o[1]); w.y = cvt_pk_bf16(o[2], o[3]); *(u32x2*)(orow + 4 * lane + 256 * j) = w; }
}

template <int I> __device__ __forceinline__ void subst_row(float (&x)[64], const LAS float* Mm, float r) {
#pragma unroll
    for (int j4 = 0; j4 < I; j4 += 4) { const f32x4 mv = *(const LAS f32x4*)(Mm + I * 64 + j4);
#pragma unroll
        for (int e = 0; e < 4; ++e) if (j4 + e < I) r -= mv[e] * x[j4 + e]; }
    x[I] = r;
    __builtin_amdgcn_sched_barrier(0);
}
template <int I> struct SubstAll {
    static __device__ __forceinline__ void run(float (&x)[64], const LAS float* Mm, const LAS bf16_t* srcc, const LAS float* scl) {
        SubstAll<I - 1>::run(x, Mm, srcc, scl);
        subst_row<I>(x, Mm, bf2f(srcc[I * 136]) * scl[I]);
    }
};
template <> struct SubstAll<-1> { static __device__ __forceinline__ void run(float (&)[64], const LAS float*, const LAS bf16_t*, const LAS float*) {} };

#define GDN_STEP_BODY(LD8, LD4) \
    bf16x8 Sb[4]; \
    _Pragma("unroll") for (int kb = 0; kb < 4; ++kb) { u32x4 w; w.x = cvt_pk_bf16(S[2 * kb][0], S[2 * kb][1]); w.y = cvt_pk_bf16(S[2 * kb][2], S[2 * kb][3]); w.z = cvt_pk_bf16(S[2 * kb + 1][0], S[2 * kb + 1][1]); w.w = cvt_pk_bf16(S[2 * kb + 1][2], S[2 * kb + 1][3]); \
        Sb[kb] = __builtin_bit_cast(bf16x8, w); } \
    bf16x8 fa[16]; u32x2 ur[4]; \
    _Pragma("unroll") for (int tt = 0; tt < 4; ++tt) { _Pragma("unroll") for (int kb = 0; kb < 4; ++kb) fa[4 * tt + kb] = LD8(Wg + (16 * tt + fr) * 128 + 32 * kb + 8 * fq); ur[tt] = LD4(Us + fr * 64 + 16 * tt + 4 * fq); } \
    f32x4 vn[4]; \
    { f32x4 P[4]; \
      _Pragma("unroll") for (int tt = 0; tt < 4; ++tt) P[tt] = (f32x4){0.f, 0.f, 0.f, 0.f}; \
      _Pragma("unroll") for (int kb = 0; kb < 4; ++kb) _Pragma("unroll") for (int tt = 0; tt < 4; ++tt) P[tt] = __builtin_amdgcn_mfma_f32_16x16x32_bf16(fa[4 * tt + kb], Sb[kb], P[tt], 0, 0, 0); \
      _Pragma("unroll") for (int tt = 0; tt < 4; ++tt) { vn[tt][0] = bflo(ur[tt].x) - P[tt][0]; vn[tt][1] = bfhi(ur[tt].x) - P[tt][1]; vn[tt][2] = bflo(ur[tt].y) - P[tt][2]; vn[tt][3] = bfhi(ur[tt].y) - P[tt][3]; } } \
    _Pragma("unroll") for (int tt = 0; tt < 4; ++tt) _Pragma("unroll") for (int kb = 0; kb < 4; ++kb) fa[4 * tt + kb] = LD8(Wg + 8192 + (16 * tt + fr) * 128 + 32 * kb + 8 * fq); \
    bf16x8 fb[6]; \
    fb[0] = LD8(Wg + 24576 + (fr) * 64 + 8 * fq); fb[1] = LD8(Wg + 24576 + (16 + fr) * 64 + 8 * fq); \
    fb[2] = LD8(Wg + 24576 + (32 + fr) * 64 + 8 * fq); fb[3] = LD8(Wg + 24576 + (32 + fr) * 64 + 32 + 8 * fq); \
    fb[4] = LD8(Wg + 24576 + (48 + fr) * 64 + 8 * fq); fb[5] = LD8(Wg + 24576 + (48 + fr) * 64 + 32 + 8 * fq); \
    bf16x8 Vb2[2]; \
    _Pragma("unroll") for (int k2 = 0; k2 < 2; ++k2) { u32x4 w; w.x = cvt_pk_bf16(vn[2 * k2][0], vn[2 * k2][1]); w.y = cvt_pk_bf16(vn[2 * k2][2], vn[2 * k2][3]); w.z = cvt_pk_bf16(vn[2 * k2 + 1][0], vn[2 * k2 + 1][1]); w.w = cvt_pk_bf16(vn[2 * k2 + 1][2], vn[2 * k2 + 1][3]); \
        Vb2[k2] = __builtin_bit_cast(bf16x8, w); } \
    f32x4 O[4]; \
    _Pragma("unroll") for (int tt = 0; tt < 4; ++tt) O[tt] = (f32x4){0.f, 0.f, 0.f, 0.f}; \
    _Pragma("unroll") for (int kb = 0; kb < 4; ++kb) _Pragma("unroll") for (int tt = 0; tt < 4; ++tt) O[tt] = __builtin_amdgcn_mfma_f32_16x16x32_bf16(fa[4 * tt + kb], Sb[kb], O[tt], 0, 0, 0); \
    O[0] = __builtin_amdgcn_mfma_f32_16x16x32_bf16(fb[0], Vb2[0], O[0], 0, 0, 0); O[1] = __builtin_amdgcn_mfma_f32_16x16x32_bf16(fb[1], Vb2[0], O[1], 0, 0, 0); \
    O[2] = __builtin_amdgcn_mfma_f32_16x16x32_bf16(fb[2], Vb2[0], O[2], 0, 0, 0); O[2] = __builtin_amdgcn_mfma_f32_16x16x32_bf16(fb[3], Vb2[1], O[2], 0, 0, 0); \
    O[3] = __builtin_amdgcn_mfma_f32_16x16x32_bf16(fb[4], Vb2[0], O[3], 0, 0, 0); O[3] = __builtin_amdgcn_mfma_f32_16x16x32_bf16(fb[5], Vb2[1], O[3], 0, 0, 0); \
    _Pragma("unroll") for (int dt = 0; dt < 8; ++dt) _Pragma("unroll") for (int k2 = 0; k2 < 2; ++k2) fa[2 * dt + k2] = LD8(Wg + 16384 + (16 * dt + fr) * 64 + 32 * k2 + 8 * fq); \
    if (tok0 >= 0 && tok0 + 64 <= Tseq) { \
        _Pragma("unroll") for (int tt = 0; tt < 4; ++tt) _Pragma("unroll") for (int jj = 0; jj < 4; ++jj) obase[(size_t)(tok0 + 16 * tt + 4 * fq + jj) * 1024] = O[tt][jj]; \
    } else { \
        _Pragma("unroll") for (int tt = 0; tt < 4; ++tt) _Pragma("unroll") for (int jj = 0; jj < 4; ++jj) { const int tk = tok0 + 16 * tt + 4 * fq + jj; if (tk >= 0 && tk < Tseq) obase[(size_t)tk * 1024] = O[tt][jj]; } \
    } \
    _Pragma("unroll") for (int dt = 0; dt < 8; ++dt) S[dt] = S[dt] * egl; \
    _Pragma("unroll") for (int k2 = 0; k2 < 2; ++k2) _Pragma("unroll") for (int dt = 0; dt < 8; ++dt) S[dt] = __builtin_amdgcn_mfma_f32_16x16x32_bf16(fa[2 * dt + k2], Vb2[k2], S[dt], 0, 0, 0);
__device__ __forceinline__ void gdn_step_lds(f32x4 (&S)[8], const LAS bf16_t* Wg, const LAS bf16_t* Us, float egl, float* obase, int tok0, int Tseq, int fr, int fq) {
#define LD8L(p) (*(const LAS bf16x8*)(p))
#define LD4L(p) (*(const LAS u32x2*)(p))
    GDN_STEP_BODY(LD8L, LD4L)
}
__device__ __forceinline__ void gdn_step_glb(f32x4 (&S)[8], const bf16_t* Wg, const bf16_t* Us, float egl, float* obase, int tok0, int Tseq, int fr, int fq) {
#define LD8G(p) (*(const bf16x8*)(p))
#define LD4G(p) (*(const u32x2*)(p))
    GDN_STEP_BODY(LD8G, LD4G)
}

#define XB_TMO      128
#define XB_XCNT(j)  (256  + 64 * (j))
#define XB_XSUB(j)  (1280 + 64 * (j))
#define XB_XGEN(j)  (2304 + 64 * (j))
#define XB_TOP      3328
#define XB_TOPGEN   3392
#define XCD_BAR_WORDS 3456
#define XB_SPIN_CAP (1u << 22)
__device__ __forceinline__ unsigned xb_ld(unsigned* p)              { return __hip_atomic_load(p, __ATOMIC_RELAXED, __HIP_MEMORY_SCOPE_AGENT); }
__device__ __forceinline__ unsigned xb_add(unsigned* p, unsigned v) { return __hip_atomic_fetch_add(p, v, __ATOMIC_RELAXED, __HIP_MEMORY_SCOPE_AGENT); }
__device__ __forceinline__ unsigned xb_xcc_id() { return (unsigned)__builtin_amdgcn_s_getreg((3 << 11) | 20) & 0xFu; }
#define XB_SPIN(cond, bar) do { unsigned _sp = 0; while (cond) { __builtin_amdgcn_s_sleep(1); \
    if ((++_sp & 255u) == 0u) { if (xb_ld(&(bar)[XB_TMO])) break; if (_sp > XB_SPIN_CAP) { atomicAdd(&(bar)[XB_TMO], 1u); break; } } } } while (0)
struct XcdBarrier { unsigned* bar; unsigned x; volatile LAS unsigned* st; };
__device__ __forceinline__ XcdBarrier xcd_barrier_post(unsigned* bar, volatile LAS unsigned* st) {
    XcdBarrier b; b.bar = bar; b.x = xb_xcc_id(); b.st = st;
    if (threadIdx.x == 0) (void)xb_add(&bar[XB_XCNT(b.x)], 1u);
    return b;
}
__device__ __forceinline__ void xcd_barrier_complete(unsigned* bar, unsigned x, unsigned& nloc, unsigned& nx) {
    const unsigned G = gridDim.x * gridDim.y * gridDim.z;
    unsigned sum, cnt, mine, sp = 0u;
    for (;;) {
        sum = 0u; cnt = 0u; mine = 0u;
#pragma unroll
        for (unsigned j = 0; j < 16; ++j) { const unsigned c = xb_ld(&bar[XB_XCNT(j)]); sum += c; cnt += (c > 0u) ? 1u : 0u; mine = (j == x) ? c : mine; }
        if (sum == G) break;
        __builtin_amdgcn_s_sleep(1);
        if ((++sp & 255u) == 0u) { if (xb_ld(&bar[XB_TMO])) break; if (sp > XB_SPIN_CAP) { atomicAdd(&bar[XB_TMO], 1u); break; } }
    }
    nloc = mine > 0u ? mine : 1u; nx = cnt > 0u ? cnt : 1u;
}
__device__ __forceinline__ void xcd_barrier(const XcdBarrier& b) {
    asm volatile("s_waitcnt vmcnt(0)" ::: "memory");
    __syncthreads();
    if (threadIdx.x == 0) {
        unsigned* bar = b.bar;
        __builtin_amdgcn_s_waitcnt(0);
        unsigned nloc = b.st[0], nx = b.st[1];
        if (nloc == 0u) { xcd_barrier_complete(bar, b.x, nloc, nx); b.st[0] = nloc; b.st[1] = nx; }
        const unsigned old = xb_add(&bar[XB_XSUB(b.x)], 1u);
        const unsigned gen = old / nloc;
        if (old + 1u == (gen + 1u) * nloc) {
            __builtin_amdgcn_fence(__ATOMIC_RELEASE, "agent");
            asm volatile("s_waitcnt vmcnt(0)" ::: "memory");
            const unsigned og = xb_add(&bar[XB_TOP], 1u);
            const unsigned tg = og / nx;
            if (og + 1u == (tg + 1u) * nx) xb_add(&bar[XB_TOPGEN], 1u);
            else XB_SPIN(xb_ld(&bar[XB_TOPGEN]) == tg, bar);
            __builtin_amdgcn_fence(__ATOMIC_ACQUIRE, "agent");
            xb_add(&bar[XB_XGEN(b.x)], 1u);
            asm volatile("s_waitcnt vmcnt(0)" ::: "memory");
        } else {
            XB_SPIN(xb_ld(&bar[XB_XGEN(b.x)]) == gen, bar);
            __builtin_amdgcn_fence(__ATOMIC_ACQUIRE, "agent");
            asm volatile("s_waitcnt vmcnt(0)" ::: "memory");
        }
    }
    __syncthreads();
}

__global__ void __launch_bounds__(512, 2) hymba_fwd(Params p) {
    extern __shared__ __attribute__((aligned(16))) unsigned char lds_raw[];
    LAS unsigned char* lds = (LAS unsigned char*)lds_raw;
    const int G = gridDim.x, bx = blockIdx.x, NGW = G * 8, NGT = G * 512;
#define PHASE_LOCALS int tid = threadIdx.x; asm volatile("" : "+v"(tid)); const int lane = tid & 63, wave = __builtin_amdgcn_readfirstlane(tid >> 6), gw = bx * 8 + wave, gtid = bx * 512 + tid; (void)gw; (void)gtid; (void)lane;
    unsigned char* ws = p.ws;
    bf16_t* Wt_in = (bf16_t*)(ws + WS_WIN); bf16_t* Wt_down = (bf16_t*)(ws + WS_WDOWN); bf16_t* Wt_out = (bf16_t*)(ws + WS_WOUT); bf16_t* Wt_up = (bf16_t*)(ws + WS_WUP);
    bf16_t* Bm = (bf16_t*)(ws + WS_B) + 2 * DM;
    bf16_t* PROJ = (bf16_t*)(ws + WS_C); float* OBUF = (float*)(ws + WS_C); bf16_t* MOb = (bf16_t*)(ws + WS_C); bf16_t* FOb = (bf16_t*)(ws + WS_B); bf16_t* Fb = (bf16_t*)(ws + WS_F);
    bf16_t* Zb = (bf16_t*)(ws + WS_Z); float* AB = (float*)(ws + WS_AB); float* PART = (float*)(ws + WS_PART); float* EGL = (float*)(ws + WS_EGL);
    unsigned char* GDN = ws + WS_GDN; bf16_t* X1 = (bf16_t*)(ws + WS_X1);
    float* out = p.out;
    if (threadIdx.x < 2) ((volatile LAS unsigned*)(lds + LDS_BYTES - 64))[threadIdx.x] = 0u;
    __syncthreads();
    const XcdBarrier xbar = xcd_barrier_post((unsigned*)ws, (volatile LAS unsigned*)(lds + LDS_BYTES - 64));

    PH(0) {
        PHASE_LOCALS
        LAS float* scr = (LAS float*)(lds + wave * 8448);
        constexpr int I_IN = 32 * 224, I_OUT = 32 * 64;
        for (int it = gw; it < I_IN + I_OUT; it += NGW) {
            if (it < I_IN) { const int kb = it / 224, nb = it - kb * 224; transpose_item(p.w_in, INC, 64 * kb, 32 * nb, Wt_in, DM, 32 * nb, scr, lane); }
            else { const int r = it - I_IN, kb = r >> 6, nb = r & 63; transpose_item(p.w_out, DM, 64 * kb, 32 * nb, Wt_out, DM, 32 * nb, scr, lane); }
        }
        for (int idx = gtid; idx < 16 * DM; idx += NGT) { const int n = idx >> 11, k = idx & 2047; Wt_in[(size_t)(7168 + n) * DM + k] = f2bf(p.w_in[(size_t)k * INC + 7168 + n]); }
        for (int idx = gtid; idx < 240 * DM / 8; idx += NGT) ((u32x4*)(Wt_in + (size_t)7184 * DM))[idx] = (u32x4){0u, 0u, 0u, 0u};
        {
            f32x4 nx[8]; const float* xr = x_row(p, gw);
#pragma unroll
            for (int j = 0; j < 8; ++j) nx[j] = xr ? *(const f32x4*)(xr + 4 * lane + 256 * j) : (f32x4){0.f, 0.f, 0.f, 0.f};
#pragma unroll 1
            for (int R = gw; R < T_PAD; R += NGW) {
                f32x4 v[8]; const bool live = xr != nullptr;
#pragma unroll
                for (int j = 0; j < 8; ++j) v[j] = nx[j];
                xr = (R + NGW < T_PAD) ? x_row(p, R + NGW) : nullptr;
                if (xr) {
#pragma unroll
                    for (int j = 0; j < 8; ++j) nx[j] = *(const f32x4*)(xr + 4 * lane + 256 * j);
                }
                bf16_t* orow = Bm + (size_t)R * DM;
                if (live) norm_store_bf16(v, p.g_pre_mix, orow, lane);
                else {
#pragma unroll
                    for (int j = 0; j < 8; ++j) *(u32x2*)(orow + 4 * lane + 256 * j) = (u32x2){0u, 0u};
                }
            }
        }
    }
    xcd_barrier(xbar);

    PH(1) {
        PHASE_LOCALS
        pg8::Gemm g{Bm, Wt_in, DM, (size_t)256 * DM * 2}; pg8::StaticOrder S; S.init(65, 29, G, bx);
        pg8::EpiProj E{PROJ, Zb, AB};
        pg8::gemm_phase<pg8::EpiProj>(lds, g, S, E);
    }
    xcd_barrier(xbar);

    PH(2) {
        PHASE_LOCALS
        const int half = tid >> 8, t = tid & 255, hw = wave & 3;
        LAS unsigned char* L = lds + half * 70656;
        LAS bf16_t* Kb = (LAS bf16_t*)L; LAS bf16_t* Qb = (LAS bf16_t*)(L + 17408); LAS bf16_t* Vb = (LAS bf16_t*)(L + 34816);
        LAS float* Mm = (LAS float*)(L + 52224); LAS float* gc = (LAS float*)(L + 68608); LAS float* bt = gc + 64; LAS float* eg = gc + 128; LAS float* bw = gc + 192; LAS float* kdv = gc + 256;
        const int fr = lane & 15, fq = lane >> 4;
        for (int pr = bx; pr < NITEM / 2; pr += G) {
            const int item = 2 * pr + half;
            int h, tok0, Tseq, rowbase, sidx; bool samp;
            if (item < NITEM_P) { const int bh = item / 65, c = item - bh * 65; sidx = bh >> 3; h = bh & 7; tok0 = 64 * c - 48; Tseq = NPT; rowbase = sidx * NPT; samp = false; }
            else { const int sh = item - NITEM_P; sidx = sh >> 3; h = sh & 7; tok0 = 0; Tseq = 16; rowbase = ROWS_P + 16 * sidx; samp = true; }
            unsigned char* blob = GDN + (size_t)item * BLOB;
            bf16_t* Wg = (bf16_t*)blob; bf16_t* QGg = Wg + 8192; bf16_t* KDTg = Wg + 16384; bf16_t* ATTg = Wg + 24576; bf16_t* UTg = Wg + 28672;
            if (t < 64) {
                const int tk = tok0 + t; float gval = 0.f, bval = 0.f;
                if (tk >= 0 && tk < Tseq) { const float* abr = AB + (size_t)(rowbase + tk) * 16; const float bl = abr[h], al = abr[8 + h] + p.dt_bias[h];
                    bval = 1.f / (1.f + __expf(-bl)); const float sp = al > 20.f ? al : log1pf(__expf(al)); gval = -__expf(p.a_log[h]) * sp; }
                float cs = gval;
#pragma unroll
                for (int o = 1; o < 64; o <<= 1) { const float y = __shfl_up(cs, o); if (lane >= o) cs += y; }
                gc[t] = cs; bt[t] = bval; eg[t] = __expf(cs); bw[t] = bval * __expf(cs); kdv[t] = __expf(__shfl(cs, 63) - cs);
            }
            { LAS float* wl = Mm;
#pragma unroll
              for (int i = 0; i < 6; ++i) { const int v = t + 256 * i, j = v / 384, r = v - j * 384; wl[v] = p.w_conv_gdn[(size_t)j * 3072 + (r >> 7) * 1024 + h * 128 + (r & 127)]; } }
            __syncthreads();
            P2(0)
#pragma unroll 1
            for (int ib = 0; ib < 3; ++ib) {
                u32x4 raw[4][4];
#pragma unroll
                for (int u = 0; u < 4; ++u) {
                    const int idx = t + 256 * (4 * ib + u), pp = idx / 48, oct = idx - pp * 48, cq = (oct >> 4) * 1024 + h * 128 + (oct & 15) * 8;
                    const int tk = tok0 + pp;
#pragma unroll
                    for (int j = 0; j < 4; ++j) { int tj = tk - j; tj = tj < 0 ? 0 : (tj >= Tseq ? Tseq - 1 : tj);
                        raw[u][j] = *(const u32x4*)(PROJ + (size_t)(rowbase + tj) * 6144 + 3072 + cq);
}
                }
#pragma unroll
                for (int u = 0; u < 4; ++u) {
                    const int idx = t + 256 * (4 * ib + u), pp = idx / 48, oct = idx - pp * 48, which = oct >> 4, d0 = (oct & 15) * 8, cq = which * 1024 + h * 128 + d0;
                    const int tk = tok0 + pp; const bool valid = (tk >= 0 && tk < Tseq);
                    float y[8];
#pragma unroll
                    for (int e = 0; e < 8; ++e) y[e] = 0.f;
#pragma unroll
                    for (int j = 0; j < 4; ++j) { const float m = (tk - j >= 0) ? 1.f : 0.f; const u32x4 r = raw[u][j]; const LAS float* wlp = Mm + (3 - j) * 384 + which * 128 + d0; const f32x4 wa = *(const LAS f32x4*)wlp * m, wb = *(const LAS f32x4*)(wlp + 4) * m;
                        y[0] += wa[0] * bflo(r.x); y[1] += wa[1] * bfhi(r.x); y[2] += wa[2] * bflo(r.y); y[3] += wa[3] * bfhi(r.y); y[4] += wb[0] * bflo(r.z); y[5] += wb[1] * bfhi(r.z); y[6] += wb[2] * bflo(r.w); y[7] += wb[3] * bfhi(r.w); }
                    if (samp && valid && tk < 3) {
#pragma unroll
                        for (int j = 1; j < 4; ++j) if (tk - j < 0) { const float* hp = p.st_gdn_conv + ((size_t)sidx * 3 + (3 + tk - j)) * 3072 + cq; const f32x4 a = *(const f32x4*)hp, bq = *(const f32x4*)(hp + 4);
                            const LAS float* wlp = Mm + (3 - j) * 384 + which * 128 + d0; const f32x4 wa = *(const LAS f32x4*)wlp, wb = *(const LAS f32x4*)(wlp + 4);
                            y[0] += wa[0] * a[0]; y[1] += wa[1] * a[1]; y[2] += wa[2] * a[2]; y[3] += wa[3] * a[3];
                            y[4] += wb[0] * bq[0]; y[5] += wb[1] * bq[1]; y[6] += wb[2] * bq[2]; y[7] += wb[3] * bq[3]; }
                    }
                    float ss = 0.f;
#pragma unroll
                    for (int e = 0; e < 8; ++e) { y[e] = valid ? silu_f(y[e]) : 0.f; ss += y[e] * y[e]; }
                    ss += __shfl_xor(ss, 1); ss += __shfl_xor(ss, 2); ss += __shfl_xor(ss, 4); ss += __shfl_xor(ss, 8);
                    float sc = 1.f;
                    if (which == 0) sc = rsqrtf(ss + EPS) * 0.08838834764831845f; else if (which == 1) sc = rsqrtf(ss + EPS);
                    u32x4 o; o.x = cvt_pk_bf16(y[0] * sc, y[1] * sc); o.y = cvt_pk_bf16(y[2] * sc, y[3] * sc); o.z = cvt_pk_bf16(y[4] * sc, y[5] * sc); o.w = cvt_pk_bf16(y[6] * sc, y[7] * sc);
                    LAS bf16_t* dst = (which == 0 ? Qb : (which == 1 ? Kb : Vb)) + pp * 136 + d0;
                    *(LAS u32x4*)dst = o;
                }
            }
            __syncthreads();
            P2(1) {
                const int ti = hw, i = 16 * ti + fr; const float gi = gc[i], bi = bt[i];
                bf16x8 ka[4], qa[4];
#pragma unroll
                for (int kb = 0; kb < 4; ++kb) { ka[kb] = *(const LAS bf16x8*)(Kb + i * 136 + kb * 32 + fq * 8); qa[kb] = *(const LAS bf16x8*)(Qb + i * 136 + kb * 32 + fq * 8); }
#pragma unroll 1
                for (int tj = 0; tj <= (ti | 1); ++tj) {
                    f32x4 kk = (f32x4){0.f, 0.f, 0.f, 0.f}, qk = kk;
                    if (tj <= ti) {
#pragma unroll
                        for (int kb = 0; kb < 4; ++kb) { const bf16x8 b = *(const LAS bf16x8*)(Kb + (16 * tj + fr) * 136 + kb * 32 + fq * 8);
                            kk = __builtin_amdgcn_mfma_f32_16x16x32_bf16(b, ka[kb], kk, 0, 0, 0); qk = __builtin_amdgcn_mfma_f32_16x16x32_bf16(b, qa[kb], qk, 0, 0, 0); }
                    }
                    const int jb = 16 * tj + 4 * fq; const f32x4 gj = *(const LAS f32x4*)(gc + jb);
                    f32x4 mrow, arow;
#pragma unroll
                    for (int jj = 0; jj < 4; ++jj) { const int j = jb + jj; const float dec = (i >= j) ? __expf(gi - gj[jj]) : 0.f; mrow[jj] = (i > j) ? bi * kk[jj] * dec : 0.f; arow[jj] = qk[jj] * dec; }
                    if (tj <= ti) *(LAS f32x4*)(Mm + i * 64 + jb) = mrow;
                    u32x2 aw; aw.x = cvt_pk_bf16(arow[0], arow[1]); aw.y = cvt_pk_bf16(arow[2], arow[3]);
                    *(u32x2*)(ATTg + i * 64 + (tj >> 1) * 32 + 8 * fq + 4 * (tj & 1)) = aw;
                }
            }
            P2(2) {
#pragma unroll
                for (int i = 0; i < 4; ++i) { const int v = t + 256 * i, tok = v >> 4, oct = v & 15, dkb = (oct >> 2) * 32 + (oct & 3) * 4; const float e = eg[tok];
                    const u32x2 lo = *(const LAS u32x2*)(Qb + tok * 136 + dkb), hi = *(const LAS u32x2*)(Qb + tok * 136 + dkb + 16);
                    u32x4 o; o.x = cvt_pk_bf16(bflo(lo.x) * e, bfhi(lo.x) * e); o.y = cvt_pk_bf16(bflo(lo.y) * e, bfhi(lo.y) * e); o.z = cvt_pk_bf16(bflo(hi.x) * e, bfhi(hi.x) * e); o.w = cvt_pk_bf16(bflo(hi.y) * e, bfhi(hi.y) * e);
                    *(u32x4*)(QGg + tok * 128 + 8 * oct) = o; }
#pragma unroll
                for (int i = 0; i < 4; ++i) { const int v = t + 256 * i, dk = v >> 3, oct = v & 7, tb = (oct >> 2) * 32 + (oct & 3) * 4; float f[8];
#pragma unroll
                    for (int e = 0; e < 8; ++e) { const int tok = tb + (e >> 2) * 16 + (e & 3); f[e] = bf2f(Kb[tok * 136 + dk]) * kdv[tok]; }
                    u32x4 o; o.x = cvt_pk_bf16(f[0], f[1]); o.y = cvt_pk_bf16(f[2], f[3]); o.z = cvt_pk_bf16(f[4], f[5]); o.w = cvt_pk_bf16(f[6], f[7]);
                    *(u32x4*)(KDTg + dk * 64 + 8 * oct) = o; }
                if (t == 0) { const float e63 = eg[63]; EGL[item] = e63; *(f32x4*)(blob + 73728) = (f32x4){e63, e63, e63, e63}; }
            }
            __syncthreads();
            P2(3) {
                float x[64];
                const bool isU = t < 128; const int c = t & 127; const LAS bf16_t* src = isU ? Vb : Kb;
                SubstAll<63>::run(x, Mm, src + c, isU ? bt : bw);
                if (isU) {
#pragma unroll
                    for (int q = 0; q < 8; ++q) { u32x4 o; o.x = cvt_pk_bf16(x[8 * q], x[8 * q + 1]); o.y = cvt_pk_bf16(x[8 * q + 2], x[8 * q + 3]); o.z = cvt_pk_bf16(x[8 * q + 4], x[8 * q + 5]); o.w = cvt_pk_bf16(x[8 * q + 6], x[8 * q + 7]);
                        *(u32x4*)(UTg + c * 64 + 8 * q) = o; }
                } else { const int pc = (c & 96) + perm32(c & 31);
#pragma unroll
                    for (int i = 0; i < 64; ++i) Qb[i * 136 + pc] = f2bf(x[i]); }
            }
            __syncthreads();
#pragma unroll
            for (int i = 0; i < 4; ++i) { const int v = t + 256 * i, row = v >> 4, oct = v & 15; *(u32x4*)(Wg + row * 128 + 8 * oct) = *(const LAS u32x4*)(Qb + row * 136 + 8 * oct); }
            __syncthreads();
        }
        P2(4) if (bx >= 48) for (int grp = (bx - 48) * 8 + wave; grp < ROWS_V / 8; grp += (G - 48) * 8) {
            const int R0 = grp * 8; int sq, t0, Tseq; bool samp;
            if (R0 < ROWS_P) { sq = R0 / NPT; t0 = R0 - sq * NPT; Tseq = NPT; samp = false; } else { sq = (R0 - ROWS_P) >> 4; t0 = (R0 - ROWS_P) & 15; Tseq = 16; samp = true; }
            const int c0 = lane * 16;
            float cm1[16], cm2[16], wa0[16], wa1[16], wa2[16], gna[16];
#pragma unroll
            for (int q = 0; q < 4; ++q) { const f32x4 a0 = *(const f32x4*)(p.w_conv_a + c0 + 4 * q), a1 = *(const f32x4*)(p.w_conv_a + 1024 + c0 + 4 * q), a2 = *(const f32x4*)(p.w_conv_a + 2048 + c0 + 4 * q), gg = *(const f32x4*)(p.g_norm_a + c0 + 4 * q);
#pragma unroll
                for (int e = 0; e < 4; ++e) { wa0[4 * q + e] = a0[e]; wa1[4 * q + e] = a1[e]; wa2[4 * q + e] = a2[e]; gna[4 * q + e] = gg[e]; } }
            if (t0 == 0) {
#pragma unroll
                for (int e = 0; e < 16; ++e) { cm2[e] = samp ? p.st_conv_a[((size_t)sq * 2 + 0) * 1024 + c0 + e] : 0.f; cm1[e] = samp ? p.st_conv_a[((size_t)sq * 2 + 1) * 1024 + c0 + e] : 0.f; }
            } else {
#pragma unroll
                for (int k = 0; k < 2; ++k) { const bf16_t* rp = PROJ + (size_t)(R0 - 2 + k) * 6144 + c0;
#pragma unroll
                    for (int q = 0; q < 2; ++q) { const u32x4 ah = *(const u32x4*)(rp + 8 * q), ac = *(const u32x4*)(rp + 1024 + 8 * q); float d[8];
                        d[0] = bflo(ah.x) * bflo(ac.x); d[1] = bfhi(ah.x) * bfhi(ac.x); d[2] = bflo(ah.y) * bflo(ac.y); d[3] = bfhi(ah.y) * bfhi(ac.y);
                        d[4] = bflo(ah.z) * bflo(ac.z); d[5] = bfhi(ah.z) * bfhi(ac.z); d[6] = bflo(ah.w) * bflo(ac.w); d[7] = bfhi(ah.w) * bfhi(ac.w);
#pragma unroll
                        for (int e = 0; e < 8; ++e) { if (k == 0) cm2[8 * q + e] = d[e]; else cm1[8 * q + e] = d[e]; } } }
            }
            u32x4 nx[6];
            { const bf16_t* rp = PROJ + (size_t)R0 * 6144 + c0;
#pragma unroll
              for (int q = 0; q < 2; ++q) { nx[3 * q] = *(const u32x4*)(rp + 8 * q); nx[3 * q + 1] = *(const u32x4*)(rp + 1024 + 8 * q); nx[3 * q + 2] = *(const u32x4*)(rp + 2048 + 8 * q); } }
#pragma unroll 1
            for (int r = 0; r < 8; ++r) {
                const int R = R0 + r, tt = t0 + r;
                u32x4 cu[6];
#pragma unroll
                for (int q = 0; q < 6; ++q) cu[q] = nx[q];
                if (r < 7) { const bf16_t* rp = PROJ + (size_t)(R + 1) * 6144 + c0;
#pragma unroll
                    for (int q = 0; q < 2; ++q) { nx[3 * q] = *(const u32x4*)(rp + 8 * q); nx[3 * q + 1] = *(const u32x4*)(rp + 1024 + 8 * q); nx[3 * q + 2] = *(const u32x4*)(rp + 2048 + 8 * q); } }
                float ca[16], v[16]; float ss = 0.f;
#pragma unroll
                for (int q = 0; q < 2; ++q) { const u32x4 ah = cu[3 * q], ac = cu[3 * q + 1], ab = cu[3 * q + 2]; float* d = ca + 8 * q; float bb[8];
                    d[0] = bflo(ah.x) * bflo(ac.x); d[1] = bfhi(ah.x) * bfhi(ac.x); d[2] = bflo(ah.y) * bflo(ac.y); d[3] = bfhi(ah.y) * bfhi(ac.y);
                    d[4] = bflo(ah.z) * bflo(ac.z); d[5] = bfhi(ah.z) * bfhi(ac.z); d[6] = bflo(ah.w) * bflo(ac.w); d[7] = bfhi(ah.w) * bfhi(ac.w);
                    bb[0] = bflo(ab.x); bb[1] = bfhi(ab.x); bb[2] = bflo(ab.y); bb[3] = bfhi(ab.y); bb[4] = bflo(ab.z); bb[5] = bfhi(ab.z); bb[6] = bflo(ab.w); bb[7] = bfhi(ab.w);
#pragma unroll
                    for (int e = 0; e < 8; ++e) { const float yv = wa2[8 * q + e] * d[e] + wa1[8 * q + e] * cm1[8 * q + e] + wa0[8 * q + e] * cm2[8 * q + e];
                        v[8 * q + e] = bb[e] * yv; ss += v[8 * q + e] * v[8 * q + e]; } }
                const float rn = rsqrtf(wave_sum(ss) * (1.f / 1024.f) + EPS);
                bf16_t* mrow = Bm + (size_t)mu_row(R) * DM + c0;
#pragma unroll
                for (int q = 0; q < 2; ++q) { float o[8];
#pragma unroll
                    for (int e = 0; e < 8; ++e) o[e] = v[8 * q + e] * rn * gna[8 * q + e];
                    u32x4 w; w.x = cvt_pk_bf16(o[0], o[1]); w.y = cvt_pk_bf16(o[2], o[3]); w.z = cvt_pk_bf16(o[4], o[5]); w.w = cvt_pk_bf16(o[6], o[7]);
                    *(u32x4*)(mrow + 8 * q) = w; }
                if (tt >= Tseq - 2) { float* d = out + (samp ? O_NCA_S : O_NCA_P) + ((size_t)sq * 2 + (tt - (Tseq - 2))) * 1024 + c0;
#pragma unroll
                    for (int e = 0; e < 16; ++e) d[e] = ca[e]; }
#pragma unroll
                for (int e = 0; e < 16; ++e) { cm2[e] = cm1[e]; cm1[e] = ca[e]; }
            }
        }
        for (int idx = gtid; idx < 12 * 3 * 3072; idx += NGT) {
            const int col = idx % 3072, r = (idx / 3072) % 3, sq = idx / 9216;
            if (sq < 4) out[O_NGC_P + ((size_t)sq * 3 + r) * 3072 + col] = bf2f(PROJ[(size_t)(sq * NPT + NPT - 3 + r) * 6144 + 3072 + col]);
            else out[O_NGC_S + ((size_t)(sq - 4) * 3 + r) * 3072 + col] = bf2f(PROJ[(size_t)(ROWS_P + (sq - 4) * 16 + 13 + r) * 6144 + 3072 + col]);
        }
    }
    xcd_barrier(xbar);

    PH(3) {
        PHASE_LOCALS
        const int fr = lane & 15, fq = lane >> 4;
        constexpr int RB = 59408;
        if (bx < 256) {
            const int x = bx & 7, y = bx >> 3, bh = x * 4 + (y >> 3), sl = y & 7, sidx = bh >> 3, h = bh & 7, item0 = bh * 65, dv0 = 16 * sl, rowbase = sidx * NPT;
            f32x4 S[8];
#pragma unroll
            for (int dt = 0; dt < 8; ++dt) S[dt] = (f32x4){0.f, 0.f, 0.f, 0.f};
            u32x4 stgA[12], stgB[12];
            const int lt = tid - 64;
#define P3_ISSUE(stg, eg, c) do { const unsigned char* bsrc = GDN + (size_t)(item0 + (c)) * BLOB; _Pragma("unroll") for (int k = 0; k < 12; ++k) { int i = lt + 320 * k; i = i > 3712 ? 3712 : i; \
                const int so = i < 3584 ? i * 16 : (i < 3712 ? 57344 + dv0 * 128 + (i - 3584) * 16 : 73728); stg[k] = *(const u32x4*)(bsrc + so); } } while (0)
#define P3_WRITE(stg, eg, c) do { LAS unsigned char* bdst = lds + ((c) & 1) * RB; _Pragma("unroll") for (int k = 0; k < 12; ++k) { int i = lt + 320 * k; i = i > 3712 ? 3712 : i; *(LAS u32x4*)(bdst + i * 16) = stg[k]; } } while (0)
#define P3_BAR() do { asm volatile("s_waitcnt lgkmcnt(0)" ::: "memory"); __builtin_amdgcn_s_barrier(); asm volatile("" ::: "memory"); } while (0)
#define P3_COMPUTE(c) do { const LAS bf16_t* Wl = (const LAS bf16_t*)(lds + ((c) & 1) * RB); \
                gdn_step_lds(S, Wl, Wl + 28672, *(const LAS float*)(Wl + 29696), OBUF + (size_t)rowbase * 1024 + h * 128 + dv0 + fr, 64 * (c) - 48, NPT, fr, fq); } while (0)
            if (wave == 0) {
                P3_BAR();
#pragma unroll 1
                for (int c = 0; c < 65; ++c) { P3_COMPUTE(c); P3_BAR(); }
            } else if (wave < 6) {
                P3_ISSUE(stgB, 0, 0); P3_ISSUE(stgA, 0, 1); P3_WRITE(stgB, 0, 0); P3_ISSUE(stgB, 0, 2);
                P3_BAR();
#pragma unroll 1
                for (int c = 0; c < 64; c += 2) {
                    P3_WRITE(stgA, 0, c + 1); if (c + 3 < 65) P3_ISSUE(stgA, 0, c + 3);
                    P3_BAR();
                    P3_WRITE(stgB, 0, c + 2); if (c + 4 < 65) P3_ISSUE(stgB, 0, c + 4);
                    P3_BAR();
                }
                P3_BAR();
            } else {
                constexpr int I_UP = 32 * 352, I_DN = 88 * 64;
                LAS float* scr = (LAS float*)(lds + 2 * RB + (wave - 6) * 8448);
                const int sw = bx * 2 + (wave - 6);
                float tr[32];
#define P3_TR_ISSUE(it) do { if ((it) < I_UP) { const int kb = (it) / 352, nb = (it) - kb * 352; transpose_issue(tr, p.w_up, 2 * DFF, 64 * kb, 32 * nb, lane); } \
                    else { const int r_ = (it) - I_UP, kb = r_ >> 6, nb = r_ & 63; transpose_issue(tr, p.w_down, DM, 64 * kb, 32 * nb, lane); } } while (0)
#define P3_TR_FINISH(it) do { if ((it) < I_UP) { const int kb = (it) / 352, nb = (it) - kb * 352, n0 = 32 * nb; const int j_ = n0 < DFF ? n0 : n0 - DFF; const int drow = 256 * (j_ >> 7) + (n0 < DFF ? 0 : 128) + (j_ & 127); \
                        transpose_finish(tr, Wt_up, DM, 64 * kb, drow, scr, lane); } \
                    else { const int r_ = (it) - I_UP, kb = r_ >> 6, nb = r_ & 63; transpose_finish(tr, Wt_down, DFF, 64 * kb, 32 * nb, scr, lane); } } while (0)
                int it = sw;
                if (it < I_UP + I_DN) P3_TR_ISSUE(it);
                P3_BAR();
#pragma unroll 1
                for (int c = 0; c < 65; ++c) {
                    if (it < I_UP + I_DN) { P3_TR_FINISH(it); it += 512; if (it < I_UP + I_DN) P3_TR_ISSUE(it); }
                    P3_BAR();
                }
#pragma unroll 1
                while (it < I_UP + I_DN) { P3_TR_FINISH(it); it += 512; if (it < I_UP + I_DN) P3_TR_ISSUE(it); }
            }
            if (wave == 0) {
                float* sd = out + O_NGD_P + ((size_t)sidx * 8 + h) * 16384;
#pragma unroll
                for (int dt = 0; dt < 8; ++dt)
#pragma unroll
                    for (int jj = 0; jj < 4; ++jj) sd[(16 * dt + 4 * fq + jj) * 128 + dv0 + fr] = S[dt][jj];
            }
        }
        if (wave < 2) {
            const int w = 2 * bx + wave;
            if (w < 512) {
                const int sh = w >> 3, sl = w & 7, sidx = sh >> 3, h = sh & 7, dv0 = 16 * sl, item = NITEM_P + sh;
                f32x4 S[8];
#pragma unroll
                for (int dt = 0; dt < 8; ++dt)
#pragma unroll
                    for (int jj = 0; jj < 4; ++jj) S[dt][jj] = p.st_gdn[(((size_t)sidx * 8 + h) * 128 + 16 * dt + 4 * fq + jj) * 128 + dv0 + fr];
                const bf16_t* Wg = (const bf16_t*)(GDN + (size_t)item * BLOB);
                gdn_step_glb(S, Wg, Wg + 28672 + dv0 * 64, EGL[item], OBUF + (size_t)(ROWS_P + sidx * 16) * 1024 + h * 128 + dv0 + fr, 0, 16, fr, fq);
                float* sd = out + O_NGD_S + ((size_t)sidx * 8 + h) * 16384;
#pragma unroll
                for (int dt = 0; dt < 8; ++dt)
#pragma unroll
                    for (int jj = 0; jj < 4; ++jj) sd[(16 * dt + 4 * fq + jj) * 128 + dv0 + fr] = S[dt][jj];
            }
        }
    }
    xcd_barrier(xbar);

    PH(4) {
        PHASE_LOCALS
        for (int R = gw; R < ROWS_V; R += NGW) {
            const int hh = lane >> 3, e0 = (lane & 7) * 16; const float* op = OBUF + (size_t)R * 1024 + hh * 128 + e0;
            f32x4 o[4]; float ss = 0.f;
#pragma unroll
            for (int q = 0; q < 4; ++q) { o[q] = *(const f32x4*)(op + 4 * q); ss += (o[q][0] * o[q][0] + o[q][1] * o[q][1]) + (o[q][2] * o[q][2] + o[q][3] * o[q][3]); }
            ss += __shfl_xor(ss, 1); ss += __shfl_xor(ss, 2); ss += __shfl_xor(ss, 4);
            const float rn = rsqrtf(ss * (1.f / 128.f) + EPS);
            const bf16_t* zp = Zb + (size_t)R * 1024 + hh * 128 + e0;
#pragma unroll
            for (int q = 0; q < 2; ++q) { const u32x4 zr = *(const u32x4*)(zp + 8 * q); float zz[8] = {bflo(zr.x), bfhi(zr.x), bflo(zr.y), bfhi(zr.y), bflo(zr.z), bfhi(zr.z), bflo(zr.w), bfhi(zr.w)}; float y[8];
#pragma unroll
                for (int e = 0; e < 8; ++e) y[e] = o[2 * q + (e >> 2)][e & 3] * rn * p.g_norm_gdn[e0 + 8 * q + e] * silu_f(zz[e]);
                u32x4 w; w.x = cvt_pk_bf16(y[0], y[1]); w.y = cvt_pk_bf16(y[2], y[3]); w.z = cvt_pk_bf16(y[4], y[5]); w.w = cvt_pk_bf16(y[6], y[7]);
                *(u32x4*)(Bm + (size_t)mu_row(R) * DM + 1024 + hh * 128 + e0 + 8 * q) = w; }
        }
    }
    xcd_barrier(xbar);

    PH(5) {
        PHASE_LOCALS
        pg8::Gemm g{Bm, Wt_out, DM, (size_t)256 * DM * 2}; pg8::StaticOrder S; S.init(64, 8, G, bx);
        pg8::EpiBf16Part E{MOb, PART};
        pg8::gemm_phase<pg8::EpiBf16Part>(lds, g, S, E);
        const int fr = lane & 15, fq = lane >> 4;
        for (int job = bx; job < 12 * 32; job += G) {
            const int rt = job % 12, cgp = job / 12;
            const bf16_t* ap = Bm + (size_t)(16384 + 16 * rt + fr) * DM + 8 * fq + wave * 256;
            const bf16_t* bp = Wt_out + (size_t)(64 * cgp + fr) * DM + 8 * fq + wave * 256;
            f32x4 acc[4];
#pragma unroll
            for (int n = 0; n < 4; ++n) acc[n] = (f32x4){0.f, 0.f, 0.f, 0.f};
#pragma unroll 2
            for (int ks = 0; ks < 8; ++ks) { const bf16x8 a = *(const bf16x8*)(ap + 32 * ks);
#pragma unroll
                for (int n = 0; n < 4; ++n) { const bf16x8 b = *(const bf16x8*)(bp + (size_t)16 * n * DM + 32 * ks); acc[n] = __builtin_amdgcn_mfma_f32_16x16x32_bf16(b, a, acc[n], 0, 0, 0); } }
            LAS f32x4* red = (LAS f32x4*)lds;
            __syncthreads();
#pragma unroll
            for (int n = 0; n < 4; ++n) red[(wave * 4 + n) * 64 + lane] = acc[n];
            __syncthreads();
            if (wave == 0) {
                float ss = 0.f; const int q = 16384 + 16 * rt + fr;
#pragma unroll
                for (int n = 0; n < 4; ++n) { f32x4 v = red[n * 64 + lane];
#pragma unroll
                    for (int w2 = 1; w2 < 8; ++w2) v += red[(w2 * 4 + n) * 64 + lane];
                    ss += (v[0] * v[0] + v[1] * v[1]) + (v[2] * v[2] + v[3] * v[3]);
                    u32x2 w; w.x = cvt_pk_bf16(v[0], v[1]); w.y = cvt_pk_bf16(v[2], v[3]); *(u32x2*)(MOb + (size_t)q * DM + 64 * cgp + 16 * n + 4 * fq) = w; }
                ss += __shfl_xor(ss, 16); ss += __shfl_xor(ss, 32);
                if (fq == 0) PART[(size_t)q * 32 + cgp] = ss;
            }
        }
    }
    xcd_barrier(xbar);

    PH(6) {
        PHASE_LOCALS
        {
            f32x4 nx[8]; u32x2 nm[8]; float nps = 0.f;
            const float* xr = x_row(p, gw - 2);
            if (xr) { const int mr = mu_row(gw - 2); nps = (lane < 32) ? PART[(size_t)mr * 32 + lane] : 0.f;
#pragma unroll
                for (int j = 0; j < 8; ++j) { const int c = 4 * lane + 256 * j; nx[j] = *(const f32x4*)(xr + c); nm[j] = *(const u32x2*)(MOb + (size_t)mr * DM + c); } }
#pragma unroll 1
            for (int R = gw - 2; R < 16768; R += NGW) {
                const bool live = xr != nullptr; f32x4 xv[8]; u32x2 mv2[8]; float ps = nps;
#pragma unroll
                for (int j = 0; j < 8; ++j) { xv[j] = nx[j]; mv2[j] = nm[j]; }
                const int Rn = R + NGW; xr = (Rn < 16768) ? x_row(p, Rn) : nullptr;
                if (xr) { const int mr = mu_row(Rn); nps = (lane < 32) ? PART[(size_t)mr * 32 + lane] : 0.f;
#pragma unroll
                    for (int j = 0; j < 8; ++j) { const int c = 4 * lane + 256 * j; nx[j] = *(const f32x4*)(xr + c); nm[j] = *(const u32x2*)(MOb + (size_t)mr * DM + c); } }
                bf16_t* orow = Bm + (size_t)R * DM;
                if (live) {
                    ps = wave_sum(ps);
                    const float rn = rsqrtf(ps * (1.f / DM) + EPS);
                    f32x4 v[8];
#pragma unroll
                    for (int j = 0; j < 8; ++j) { const int c = 4 * lane + 256 * j; const f32x4 gg = *(const f32x4*)(p.g_post_mix + c); const f32x4 mv = (f32x4){bflo(mv2[j].x), bfhi(mv2[j].x), bflo(mv2[j].y), bfhi(mv2[j].y)};
                        v[j] = xv[j] + mv * rn * gg; u32x2 xw; xw.x = cvt_pk_bf16(v[j][0], v[j][1]); xw.y = cvt_pk_bf16(v[j][2], v[j][3]); *(u32x2*)(X1 + (size_t)R * DM + c) = xw; }
                    norm_store_bf16(v, p.g_pre_ffn, orow, lane);
                } else {
#pragma unroll
                    for (int j = 0; j < 8; ++j) *(u32x2*)(orow + 4 * lane + 256 * j) = (u32x2){0u, 0u};
                }
            }
        }
    }
    xcd_barrier(xbar);

    PH(7) {
        PHASE_LOCALS
        pg8::Gemm g{Bm - 2 * DM, Wt_up, DM, (size_t)254 * DM * 2}; pg8::StaticOrder S; S.init(66, 44, G, bx);
        pg8::EpiGate E{Fb, p.w_conv_ffn, p.st_ffn_conv, out, (LAS float*)(lds + pg8::STAGE_BYTES)};
        pg8::gemm_phase<pg8::EpiGate>(lds, g, S, E);
    }
    xcd_barrier(xbar);

    PH(9) {
        PHASE_LOCALS
        pg8::Gemm g{Fb, Wt_down, DFF, (size_t)256 * DFF * 2}; pg8::PanelOrder S{bx};
        pg8::EpiFinal E{out + O_YP, X1, p.g_post_ffn, (float*)(ws + 512 * 1024), (unsigned*)ws + 8192, (LAS float*)(lds + pg8::STAGE_BYTES)};
        if (G == 256) pg8::gemm_phase<pg8::EpiFinal, pg8::PanelOrder>(lds, g, S, E);
        if (bx < 256) {
            const int fr = lane & 15, fq = lane >> 4, rt = bx & 7, cgp = bx >> 3;
            const bf16_t* ap = Fb + (size_t)(16384 + 16 * rt + fr) * DFF + 8 * fq + wave * 704;
            const bf16_t* bp = Wt_down + (size_t)(64 * cgp + fr) * DFF + 8 * fq + wave * 704;
            f32x4 acc[4];
#pragma unroll
            for (int n = 0; n < 4; ++n) acc[n] = (f32x4){0.f, 0.f, 0.f, 0.f};
#pragma unroll 2
            for (int ks = 0; ks < 22; ++ks) { const bf16x8 a = *(const bf16x8*)(ap + 32 * ks);
#pragma unroll
                for (int n = 0; n < 4; ++n) { const bf16x8 b = *(const bf16x8*)(bp + (size_t)16 * n * DFF + 32 * ks); acc[n] = __builtin_amdgcn_mfma_f32_16x16x32_bf16(b, a, acc[n], 0, 0, 0); } }
            LAS f32x4* red = (LAS f32x4*)lds;
#pragma unroll
            for (int n = 0; n < 4; ++n) red[(wave * 4 + n) * 64 + lane] = acc[n];
            __syncthreads();
            if (wave == 0) {
                float ss = 0.f; const int q = 16384 + 16 * rt + fr;
#pragma unroll
                for (int n = 0; n < 4; ++n) { f32x4 v = red[n * 64 + lane];
#pragma unroll
                    for (int w2 = 1; w2 < 8; ++w2) v += red[(w2 * 4 + n) * 64 + lane];
                    ss += (v[0] * v[0] + v[1] * v[1]) + (v[2] * v[2] + v[3] * v[3]);
                    u32x2 w; w.x = cvt_pk_bf16(v[0], v[1]); w.y = cvt_pk_bf16(v[2], v[3]); *(u32x2*)(FOb + (size_t)q * DM + 64 * cgp + 16 * n + 4 * fq) = w; }
                ss += __shfl_xor(ss, 16); ss += __shfl_xor(ss, 32);
                if (fq == 0) PART[(size_t)q * 32 + cgp] = ss;
            }
        }
    }
    xcd_barrier(xbar);

    PH(10) {
        PHASE_LOCALS
        for (int q = 16384 + gw; q < 16384 + 128; q += NGW) {
            int R; float* yrow;
            if (q < 16384) { const int b = q >> 12, t = q & 4095; R = b * NPT + 16 + t; yrow = out + O_YP + (size_t)q * DM; } else { R = ROWS_P + (q - 16384); yrow = out + O_YS + (size_t)(q - 16384) * DM; }
            float ps = (lane < 32) ? PART[(size_t)q * 32 + lane] : 0.f; ps = wave_sum(ps);
            const float rn = rsqrtf(ps * (1.f / DM) + EPS);
#pragma unroll
            for (int j = 0; j < 8; ++j) { const int c = 4 * lane + 256 * j; const f32x4 gg = *(const f32x4*)(p.g_post_ffn + c); const u32x2 fr2 = *(const u32x2*)(FOb + (size_t)q * DM + c); const f32x4 fv = (f32x4){bflo(fr2.x), bfhi(fr2.x), bflo(fr2.y), bfhi(fr2.y)}; const u32x2 xr2 = *(const u32x2*)(X1 + (size_t)R * DM + c); const f32x4 xv = (f32x4){bflo(xr2.x), bfhi(xr2.x), bflo(xr2.y), bfhi(xr2.y)};
                *(f32x4*)(yrow + c) = xv + fv * rn * gg; }
        }
    }
}

extern "C" void kernel_launch(void* const* d_in, const int* in_sizes, int n_in, void* d_out, int out_size, void* d_ws, size_t ws_size, hipStream_t stream) {
    static int grid = 0;
    if (grid == 0) {
        if (n_in != 22 || (size_t)out_size != O_END || ws_size < WS_END) { fprintf(stderr, "kernel_launch: unexpected shapes: n_in %d out %d ws %zu\n", n_in, out_size, ws_size); grid = -1; return; }
        int dev = 0, cus = 0, per_cu = 0;
        hipGetDevice(&dev); hipDeviceGetAttribute(&cus, hipDeviceAttributeMultiprocessorCount, dev);
        hipFuncSetAttribute((const void*)hymba_fwd, hipFuncAttributeMaxDynamicSharedMemorySize, LDS_BYTES);
        hipOccupancyMaxActiveBlocksPerMultiprocessor(&per_cu, (const void*)hymba_fwd, 512, LDS_BYTES);
        if (per_cu < 1) { fprintf(stderr, "kernel_launch: occupancy query says %d blocks per CU\n", per_cu); per_cu = 1; }
        grid = cus;
        (void)hipGetLastError();
    }
    if (grid < 0) return;
    (void)hipMemsetAsync(d_ws, 0, 65536, stream);
    Params p{};
    const float** pp = (const float**)&p;
    for (int i = 0; i < 22; ++i) pp[i] = (const float*)d_in[i];
    p.out = (float*)d_out; p.ws = (unsigned char*)d_ws;
    void* args[] = {&p};
    hipError_t e = hipLaunchCooperativeKernel((const void*)hymba_fwd, dim3(grid), dim3(512), args, LDS_BYTES, stream);
    if (e != hipSuccess) fprintf(stderr, "cooperative launch failed: %s (grid %d)\n", hipGetErrorString(e), grid);
}
```

```cpp
#include <hip/hip_runtime.h>
#include <hip/hip_cooperative_groups.h>
#include <cstdio>
#include <cstdint>
namespace cg = cooperative_groups;

#define LAS __attribute__((address_space(3)))
typedef unsigned short bf16_t;
typedef short bf16x8 __attribute__((ext_vector_type(8)));
typedef float f32x4 __attribute__((ext_vector_type(4)));
typedef unsigned u32x4 __attribute__((ext_vector_type(4)));
typedef unsigned u32x2 __attribute__((ext_vector_type(2)));

constexpr int DM = 2048, NPT = 4112  , ROWS_P = 4 * NPT  , ROWS_V = ROWS_P + 128  , T_PAD = 16640;
constexpr int DFF = 5632, INC = 7184;
constexpr int NITEM_P = 4 * 8 * 65, NITEM = NITEM_P + 64;
constexpr float EPS = 1e-6f;
constexpr size_t O_YP = 0, O_YS = 33554432, O_NCA_P = 33816576, O_NGC_P = 33824768, O_NGD_P = 33861632, O_NFC_P = 34385920,
                 O_NCA_S = 34430976, O_NGC_S = 34447360, O_NGD_S = 34521088, O_NFC_S = 35569664, O_END = 35659776;
constexpr size_t MiB = 1u << 20;
constexpr size_t WS_PART = 1 * MiB;
constexpr size_t WS_EGL = 3 * MiB + 512 * 1024;
constexpr size_t WS_WIN = 4 * MiB;
constexpr size_t WS_WDOWN = 4 * MiB;
constexpr size_t WS_WOUT = 33 * MiB;
constexpr size_t WS_B = 41 * MiB;
constexpr size_t WS_C = 107 * MiB;
constexpr size_t WS_Z = 302 * MiB;
constexpr size_t WS_AB = 334 * MiB + 768 * 1024;
constexpr size_t WS_GDN = 336 * MiB;
constexpr size_t WS_X1 = 445 * MiB;
constexpr size_t WS_WUP = 172 * MiB;
constexpr size_t WS_F = 216 * MiB;
constexpr size_t WS_END = 510 * MiB;
constexpr size_t BLOB = 73984;
static_assert(WS_Z + (size_t)T_PAD * 2048 <= WS_AB && WS_AB + (size_t)T_PAD * 64 <= WS_GDN && WS_GDN + (size_t)NITEM * BLOB <= 488 * MiB && WS_PART + (size_t)T_PAD * 128 <= WS_EGL, "ws map");
constexpr int LDS_BYTES = 147456;
#ifndef PHASE_MASK
#define PHASE_MASK 0xFFFF
#endif
#ifndef P2MASK
#define P2MASK 0xFF
#endif
#define P2(n) if constexpr (((P2MASK) >> (n)) & 1)
#ifndef REPEAT_MASK
#define REPEAT_MASK 0
#endif
#ifndef EXTRA_SYNCS
#define EXTRA_SYNCS 0
#endif
#define PH(n) if constexpr (((PHASE_MASK) >> (n)) & 1)

__device__ __forceinline__ unsigned cvt_pk_bf16(float lo, float hi) { unsigned r; asm volatile("v_cvt_pk_bf16_f32 %0, %1, %2" : "=v"(r) : "v"(lo), "v"(hi)); return r; }
__device__ __forceinline__ unsigned short f2bf(float f) { return (unsigned short)(cvt_pk_bf16(f, 0.f) & 0xffffu); }
__device__ __forceinline__ float bf2f(unsigned short b) { return __uint_as_float((unsigned)b << 16); }
__device__ __forceinline__ float bflo(unsigned w) { return __uint_as_float(w << 16); }
__device__ __forceinline__ float bfhi(unsigned w) { return __uint_as_float(w & 0xffff0000u); }
__device__ __forceinline__ float wave_sum(float v) {
#pragma unroll
    for (int o = 1; o < 64; o <<= 1) v += __shfl_xor(v, o);
    return v;
}
__device__ __forceinline__ float silu_f(float x) { return x * __builtin_amdgcn_rcpf(1.f + __expf(-x)); }
__device__ __forceinline__ int perm32(int k) { return ((k >> 2) & 3) * 8 + ((k >> 4) & 1) * 4 + (k & 3); }
#define LDS_WAIT() asm volatile("s_waitcnt lgkmcnt(0)" ::: "memory")

struct Params {
    const float *xp, *xs, *st_conv_a, *st_gdn_conv, *st_gdn, *st_ffn_conv, *meta, *g_pre_mix, *w_in, *w_conv_a, *g_norm_a, *w_conv_gdn,
                *a_log, *dt_bias, *g_norm_gdn, *w_out, *g_post_mix, *g_pre_ffn, *w_up, *w_conv_ffn, *w_down, *g_post_ffn;
    float* out; unsigned char* ws;
};
__device__ __forceinline__ const float* x_row(const Params& p, int R) {
    if (R < 0) return nullptr;
    if (R < ROWS_P) { const int b = R / NPT, t = R - b * NPT; return t < 16 ? p.meta + (size_t)t * DM : p.xp + ((size_t)b * 4096 + (t - 16)) * DM; }
    if (R < ROWS_V) return p.xs + (size_t)(R - ROWS_P) * DM;
    return nullptr;
}

__device__ __forceinline__ int mu_row(int R) {
    if (R < ROWS_P) { const int b = R / NPT, t = R - b * NPT; return t >= 16 ? b * 4096 + (t - 16) : 16512 + b * 16 + t; }
    return 16384 + (R - ROWS_P);
}

namespace pg8 {
constexpr int BM = 256, BK = 64, HALF = 128, HTB = HALF * BK * 2, STAGE_BYTES = 8 * HTB, NXCD = 8, WGM = 8;
__host__ __device__ __forceinline__ int lds_byte(int r, int c) { const int st = (r >> 4) * 2 + (c >> 5), rr = r & 15, cc = c & 31, ob = rr * 64 + cc * 2; return st * 1024 + (ob ^ (((ob >> 9) & 1) << 5)); }
__host__ __device__ __forceinline__ void stage_rc(int b, int& R, int& C) { const int st = b / 1024, sb = b % 1024, swz = sb ^ (((sb >> 9) & 1) << 5); R = (st >> 1) * 16 + swz / 64; C = (st & 1) * 32 + (swz % 64) / 2; }
__host__ __device__ __forceinline__ int permB(int rho) { const int n = rho >> 4, i = rho & 15; return 8 * (i >> 2) + 4 * n + (i & 3); }
struct Unit { int pm, pn; };
struct Gemm { const bf16_t* A; const bf16_t* Bt; int K; size_t a_tstep; };
struct StaticOrder {
    int nM, nN, nwg, G, c;
    __device__ void init(int nM_, int nN_, int G_, int c_) { nM = nM_; nN = nN_; nwg = nM * nN; G = G_; c = c_; }
    __device__ bool next(int i, Unit& u) const {
        const long L = (long)i * G + c; if (L >= nwg) return false;
        int wgid = (int)L; { const int q = nwg / NXCD, r = nwg % NXCD, xcd = wgid % NXCD, off = wgid / NXCD; wgid = (xcd < r ? xcd * (q + 1) : r * (q + 1) + (xcd - r) * q) + off; }
        const int nig = WGM * nN, gid = wgid / nig, fm = gid * WGM, gsz = (nM - fm) < WGM ? (nM - fm) : WGM;
        u.pm = fm + ((wgid % nig) % gsz); u.pn = (wgid % nig) / gsz; return true;
    }
};
struct PanelOrder {
    int c;
    __device__ bool next(int i, Unit& u) const { if (i >= 2) return false; const int x = c & 7, j = c >> 3; u.pm = 32 * i + 4 * x + (j >> 3); u.pn = j & 7; return true; }
};
template <class Epi, class Sched = StaticOrder>
__device__ __forceinline__ void gemm_phase(LAS unsigned char* lds, const Gemm g, const Sched& S, const Epi& E) {
    int tid_ = threadIdx.x; asm volatile("" : "+v"(tid_));
    const int tid = tid_, wid = __builtin_amdgcn_readfirstlane(tid >> 6), lane = tid & 63, wr = wid >> 2, wc = wid & 3, fr = lane & 15, fq = lane >> 4;
    const int K = g.K, nt = K / BK;
    unsigned voffA[2], voffB[2];
#pragma unroll
    for (int i = 0; i < 2; ++i) { int R, C; stage_rc(tid * 16 + i * 8192, R, C); const int Rb = Epi::PERM ? ((R & ~31) + permB(R & 31)) : R;
        voffA[i] = (unsigned)(R * K + C) * 2u; voffB[i] = (unsigned)(Rb * K + C) * 2u; }
    const size_t kstep = (size_t)(BK * 2);
    const size_t hstep = (size_t)HALF * K * 2;
    const size_t tstepB = 2 * hstep, tstepA = g.a_tstep;
    const unsigned ldsw = (unsigned)wid * 1024u;
    const int aoff = lds_byte(wr * 64 + fr, fq * 8), boff = lds_byte(wc * 32 + fr, fq * 8);
#define PG8_SA(b, h) (((b) * 2 + (h)) * HTB)
#define PG8_SB(b, h) ((4 + (b) * 2 + (h)) * HTB)
#define PG8_STAGE(bufoff, gbase, voff) do { _Pragma("unroll") for (int _i = 0; _i < 2; ++_i) \
        __builtin_amdgcn_global_load_lds((const unsigned*)((const char*)(gbase) + (voff)[_i]), (LAS unsigned*)(lds + (bufoff) + ldsw + _i * 8192), 16, 0, 0); } while (0)
#define PG8_LDA(dst, b, h) do { _Pragma("unroll") for (int m = 0; m < 4; ++m) _Pragma("unroll") for (int k = 0; k < 2; ++k) dst[m][k] = *(const LAS bf16x8*)(lds + PG8_SA(b, h) + aoff + m * 2048 + k * 1024); } while (0)
#define PG8_LDB(dst, b, h) do { _Pragma("unroll") for (int n = 0; n < 2; ++n) _Pragma("unroll") for (int k = 0; k < 2; ++k) dst[n][k] = *(const LAS bf16x8*)(lds + PG8_SB(b, h) + boff + n * 2048 + k * 1024); } while (0)
#define PG8_MMA(ai, bj, At, Bt) do { __builtin_amdgcn_s_setprio(1); _Pragma("unroll") for (int m = 0; m < 4; ++m) _Pragma("unroll") for (int n = 0; n < 2; ++n) _Pragma("unroll") for (int k = 0; k < 2; ++k) \
        acc[ai][bj][m][n] = __builtin_amdgcn_mfma_f32_16x16x32_bf16(Bt[n][k], At[m][k], acc[ai][bj][m][n], 0, 0, 0); __builtin_amdgcn_s_setprio(0); } while (0)
#define PG8_WAIT_V(n) asm volatile("s_waitcnt vmcnt(" #n ")" ::: "memory")
#define PG8_WAIT_L(n) asm volatile("s_waitcnt lgkmcnt(" #n ")" ::: "memory")
#define PG8_BAR __builtin_amdgcn_s_barrier()
#define PG8_SCHED __builtin_amdgcn_sched_barrier(0)
    Unit cur, nxt; int ui = 0;
    if (!S.next(0, cur)) return;
    f32x4 acc[2][2][4][2];
#pragma unroll
    for (int a = 0; a < 2; ++a)
#pragma unroll
        for (int b = 0; b < 2; ++b)
#pragma unroll
            for (int m = 0; m < 4; ++m)
#pragma unroll
                for (int n = 0; n < 2; ++n) acc[a][b][m][n] = (f32x4){0.f, 0.f, 0.f, 0.f};
    bf16x8 At[4][2], B0[2][2], B1[2][2];
    const char* cA = (const char*)g.A + (size_t)cur.pm * tstepA; const char* cB = (const char*)g.Bt + (size_t)cur.pn * tstepB;
    PG8_STAGE(PG8_SB(0, 0), cB, voffB); PG8_STAGE(PG8_SB(0, 1), cB + hstep, voffB); PG8_STAGE(PG8_SA(0, 0), cA, voffA); PG8_STAGE(PG8_SA(0, 1), cA + hstep, voffA);
    if (wr == 1) PG8_BAR;
    PG8_WAIT_V(2); PG8_BAR;
    PG8_STAGE(PG8_SB(1, 0), cB + kstep, voffB); PG8_STAGE(PG8_SA(1, 0), cA + kstep, voffA); PG8_STAGE(PG8_SB(1, 1), cB + hstep + kstep, voffB);
    PG8_WAIT_V(6); PG8_BAR;
    for (;;) {
        const bool has_next = S.next(ui + 1, nxt);
        const char* nA = has_next ? (const char*)g.A + (size_t)nxt.pm * tstepA : cA; const char* nB = has_next ? (const char*)g.Bt + (size_t)nxt.pn * tstepB : cB;
        for (int t = 0; t < nt; t += 2) {
            const bool last = (t == nt - 2);
            const char* a1 = cA + (size_t)(t + 1) * kstep;
            const char* a2 = last ? nA : cA + (size_t)(t + 2) * kstep; const char* b2 = last ? nB : cB + (size_t)(t + 2) * kstep;
            const char* a3 = a2 + kstep; const char* b3 = b2 + kstep;
            PG8_LDB(B0, 0, 0); PG8_LDB(B1, 0, 1); PG8_SCHED; PG8_LDA(At, 0, 0); PG8_STAGE(PG8_SA(1, 1), a1 + hstep, voffA);
            PG8_WAIT_V(8); PG8_WAIT_L(0); PG8_BAR; PG8_MMA(0, 0, At, B0); PG8_MMA(0, 1, At, B1); PG8_BAR; PG8_SCHED;
            PG8_LDA(At, 0, 1); PG8_STAGE(PG8_SB(0, 0), b2, voffB); PG8_STAGE(PG8_SB(0, 1), b2 + hstep, voffB); PG8_STAGE(PG8_SA(0, 0), a2, voffA);
            PG8_WAIT_V(8); PG8_WAIT_L(0); PG8_BAR; PG8_MMA(1, 0, At, B0); PG8_MMA(1, 1, At, B1); PG8_BAR; PG8_SCHED;
            PG8_LDB(B0, 1, 0); PG8_LDB(B1, 1, 1); PG8_SCHED; PG8_LDA(At, 1, 0); PG8_STAGE(PG8_SA(0, 1), a2 + hstep, voffA);
            PG8_WAIT_V(8); PG8_WAIT_L(0); PG8_BAR; PG8_MMA(0, 0, At, B0); PG8_MMA(0, 1, At, B1); PG8_BAR; PG8_SCHED;
            PG8_LDA(At, 1, 1); PG8_STAGE(PG8_SB(1, 0), b3, voffB); PG8_STAGE(PG8_SB(1, 1), b3 + hstep, voffB); PG8_STAGE(PG8_SA(1, 0), a3, voffA);
            PG8_WAIT_V(8); PG8_WAIT_L(0); PG8_BAR; PG8_MMA(1, 0, At, B0); PG8_MMA(1, 1, At, B1); PG8_BAR; PG8_SCHED;
        }
        if (wr == 0) PG8_BAR;
        E(acc, cur, wr, wc, fr, fq);
        if (!has_next) break;
#pragma unroll
        for (int a = 0; a < 2; ++a)
#pragma unroll
            for (int b = 0; b < 2; ++b)
#pragma unroll
                for (int m = 0; m < 4; ++m)
#pragma unroll
                    for (int n = 0; n < 2; ++n) acc[a][b][m][n] = (f32x4){0.f, 0.f, 0.f, 0.f};
        cur = nxt; cA = nA; cB = nB; ++ui;
        if (wr == 1) PG8_BAR;
    }
    PG8_WAIT_V(0);
    PG8_BAR;
#undef PG8_SA
#undef PG8_SB
#undef PG8_STAGE
#undef PG8_LDA
#undef PG8_LDB
#undef PG8_MMA
#undef PG8_WAIT_V
#undef PG8_WAIT_L
#undef PG8_BAR
#undef PG8_SCHED
}

struct EpiProj {
    static constexpr bool PERM = true;
    bf16_t* proj; bf16_t* z; float* ab;
    __device__ __forceinline__ void operator()(const f32x4 (&acc)[2][2][4][2], const Unit& u, int wr, int wc, int fr, int fq) const {
        const int row0 = u.pm * BM + wr * 64 + fr;
        if (u.pn < 28) {
            bf16_t* base; int ldc;
            if (u.pn < 24) { base = proj + u.pn * 256 + wc * 32 + 8 * fq; ldc = 6144; } else { base = z + (u.pn - 24) * 256 + wc * 32 + 8 * fq; ldc = 1024; }
#pragma unroll
            for (int ai = 0; ai < 2; ++ai)
#pragma unroll
                for (int m = 0; m < 4; ++m) { bf16_t* rowp = base + (size_t)(row0 + ai * HALF + m * 16) * ldc;
#pragma unroll
                    for (int bj = 0; bj < 2; ++bj) { const f32x4 v0 = acc[ai][bj][m][0], v1 = acc[ai][bj][m][1];
                        u32x4 w; w.x = cvt_pk_bf16(v0[0], v0[1]); w.y = cvt_pk_bf16(v0[2], v0[3]); w.z = cvt_pk_bf16(v1[0], v1[1]); w.w = cvt_pk_bf16(v1[2], v1[3]);
                        *(u32x4*)(rowp + bj * HALF) = w; } }
        } else if (wc == 0 && fq < 2) {
#pragma unroll
            for (int ai = 0; ai < 2; ++ai)
#pragma unroll
                for (int m = 0; m < 4; ++m) { float* rowp = ab + (size_t)(row0 + ai * HALF + m * 16) * 16 + 8 * fq;
                    *(f32x4*)(rowp) = acc[ai][0][m][0]; *(f32x4*)(rowp + 4) = acc[ai][0][m][1]; }
        }
    }
};
struct EpiBf16Part {
    static constexpr bool PERM = false;
    bf16_t* outb; float* part;
    __device__ __forceinline__ void operator()(const f32x4 (&acc)[2][2][4][2], const Unit& u, int wr, int wc, int fr, int fq) const {
#pragma unroll
        for (int ai = 0; ai < 2; ++ai)
#pragma unroll
            for (int m = 0; m < 4; ++m) {
                const int r = u.pm * BM + ai * HALF + wr * 64 + m * 16 + fr;
                bf16_t* rowp = outb + (size_t)r * DM + u.pn * BM + wc * 32 + 4 * fq;
                float ss = 0.f;
#pragma unroll
                for (int bj = 0; bj < 2; ++bj)
#pragma unroll
                    for (int n = 0; n < 2; ++n) { const f32x4 v = acc[ai][bj][m][n]; ss += (v[0] * v[0] + v[1] * v[1]) + (v[2] * v[2] + v[3] * v[3]);
                        u32x2 w; w.x = cvt_pk_bf16(v[0], v[1]); w.y = cvt_pk_bf16(v[2], v[3]); *(u32x2*)(rowp + bj * HALF + n * 16) = w; }
                ss += __shfl_xor(ss, 16); ss += __shfl_xor(ss, 32);
                if (fq == 0) part[(size_t)r * 32 + u.pn * 4 + wc] = ss;
            }
    }
};
struct EpiFinal {
    static constexpr bool PERM = false;
    float* yout; const bf16_t* x1; const float* g; float* xbuf; unsigned* cnt; LAS float* ex;
    __device__ __forceinline__ void operator()(const f32x4 (&acc)[2][2][4][2], const Unit& u, int wr, int wc, int fr, int fq) const {
        const int tid = threadIdx.x;
        LAS float* P = ex; LAS float* RN = ex + 1024; LAS unsigned* flag = (LAS unsigned*)(ex + 1280);
#pragma unroll
        for (int ai = 0; ai < 2; ++ai)
#pragma unroll
            for (int m = 0; m < 4; ++m) { float ss = 0.f;
#pragma unroll
                for (int bj = 0; bj < 2; ++bj)
#pragma unroll
                    for (int n = 0; n < 2; ++n) { const f32x4 v = acc[ai][bj][m][n]; ss += (v[0] * v[0] + v[1] * v[1]) + (v[2] * v[2] + v[3] * v[3]); }
                ss += __shfl_xor(ss, 16); ss += __shfl_xor(ss, 32);
                if (fq == 0) P[(ai * HALF + wr * 64 + m * 16 + fr) * 4 + wc] = ss; }
        asm volatile("s_waitcnt lgkmcnt(0)" ::: "memory"); __builtin_amdgcn_s_barrier(); asm volatile("" ::: "memory");
        if (tid < 256) { const f32x4 pv = *(const LAS f32x4*)(P + tid * 4);
            __hip_atomic_store(xbuf + (size_t)(u.pm * 8 + u.pn) * 256 + tid, (pv[0] + pv[1]) + (pv[2] + pv[3]), __ATOMIC_RELAXED, __HIP_MEMORY_SCOPE_AGENT); }
        asm volatile("s_waitcnt vmcnt(0)" ::: "memory"); __builtin_amdgcn_s_barrier(); asm volatile("" ::: "memory");
        if (tid == 0) {
            __builtin_amdgcn_fence(__ATOMIC_RELEASE, "agent");
            __hip_atomic_fetch_add(cnt + 64 * u.pm, 1u, __ATOMIC_RELAXED, __HIP_MEMORY_SCOPE_AGENT);
            unsigned sp = 0u; while (__hip_atomic_load(cnt + 64 * u.pm, __ATOMIC_RELAXED, __HIP_MEMORY_SCOPE_AGENT) < 8u && sp < (1u << 24)) { __builtin_amdgcn_s_sleep(1); ++sp; }
            __builtin_amdgcn_fence(__ATOMIC_ACQUIRE, "agent");
            flag[0] = 1u;
        }
        asm volatile("s_waitcnt vmcnt(0) lgkmcnt(0)" ::: "memory"); __builtin_amdgcn_s_barrier(); asm volatile("" ::: "memory");
        if (tid < 256) { float tot = 0.f;
#pragma unroll
            for (int t8 = 0; t8 < 8; ++t8) tot += __hip_atomic_load(xbuf + (size_t)(u.pm * 8 + t8) * 256 + tid, __ATOMIC_RELAXED, __HIP_MEMORY_SCOPE_AGENT);
            RN[tid] = rsqrtf(tot * (1.f / DM) + EPS); }
        asm volatile("s_waitcnt vmcnt(0) lgkmcnt(0)" ::: "memory"); __builtin_amdgcn_s_barrier(); asm volatile("" ::: "memory");
        const int col0 = u.pn * BM + wc * 32 + 4 * fq;
#pragma unroll
        for (int ai = 0; ai < 2; ++ai)
#pragma unroll
            for (int m = 0; m < 4; ++m) {
                const int rl = ai * HALF + wr * 64 + m * 16 + fr, q = u.pm * BM + rl; const float rn = RN[rl];
                const int R = (q >> 12) * NPT + 16 + (q & 4095);
                const bf16_t* xp = x1 + (size_t)R * DM + col0; float* yp = yout + (size_t)q * DM + col0;
#pragma unroll
                for (int bj = 0; bj < 2; ++bj)
#pragma unroll
                    for (int n = 0; n < 2; ++n) { const int co = bj * HALF + n * 16; const u32x2 xr2 = *(const u32x2*)(xp + co); const f32x4 gg = *(const f32x4*)(g + col0 + co);
                        const f32x4 xv = (f32x4){bflo(xr2.x), bfhi(xr2.x), bflo(xr2.y), bfhi(xr2.y)};
                        *(f32x4*)(yp + co) = xv + acc[ai][bj][m][n] * rn * gg; }
            }
    }
};
struct EpiGate {
    static constexpr bool PERM = true;
    bf16_t* F; const float* wcf; const float* st_ffn; float* outb; LAS float* exch;
    __device__ __forceinline__ void operator()(const f32x4 (&acc)[2][2][4][2], const Unit& u, int wr, int wc, int fr, int fq) const {
        const int lane = fr + 16 * fq;
        if (fr >= 14) {
#pragma unroll
            for (int ai = 0; ai < 2; ++ai)
#pragma unroll
                for (int n = 0; n < 2; ++n) *(LAS f32x4*)(exch + (((((ai * 2 + wr) * 4 + wc) * 2 + (fr - 14)) * 2 + n) * 16) + fq * 4) = acc[ai][0][3][n];
        }
        asm volatile("s_waitcnt lgkmcnt(0)" ::: "memory"); __builtin_amdgcn_s_barrier(); asm volatile("" ::: "memory");
        const int j0 = u.pn * 128 + wc * 32 + 8 * fq;
        f32x4 w0[2], w1[2], w2[2];
#pragma unroll
        for (int n = 0; n < 2; ++n) { w0[n] = *(const f32x4*)(wcf + j0 + 4 * n); w1[n] = *(const f32x4*)(wcf + DFF + j0 + 4 * n); w2[n] = *(const f32x4*)(wcf + 2 * DFF + j0 + 4 * n); }
        const int src1 = (lane & 48) | ((fr - 1) & 15), src2 = (lane & 48) | ((fr - 2) & 15);
#pragma unroll
        for (int ai = 0; ai < 2; ++ai) {
            const int sl = 2 * ai + wr;
            f32x4 gprev[2];
#pragma unroll
            for (int n = 0; n < 2; ++n) { gprev[n] = (f32x4){0.f, 0.f, 0.f, 0.f};
                if (sl > 0 && fr >= 14) gprev[n] = *(const LAS f32x4*)(exch + ((((sl - 1) * 4 + wc) * 2 + (fr - 14)) * 2 + n) * 16 + fq * 4); }
#pragma unroll
            for (int m = 0; m < 4; ++m) {
                const int lr = ai * HALF + wr * 64 + m * 16 + fr, R = u.pm * 254 - 2 + lr;
                int t, Tseq, sq; bool samp = false;
                if (R < ROWS_P) { sq = R / NPT; t = R - sq * NPT; Tseq = NPT; if (R < 0) { sq = 0; t = 100; } }
                else { samp = true; sq = (R - ROWS_P) >> 4; t = (R - ROWS_P) & 15; Tseq = 16; }
                const bool valid = (lr >= 2) && (R < ROWS_V);
                u32x4 pk;
#pragma unroll
                for (int n = 0; n < 2; ++n) {
                    const f32x4 cur = acc[ai][0][m][n]; const f32x4 pm = (m == 0) ? gprev[n] : acc[ai][0][m == 0 ? 0 : m - 1][n];
                    f32x4 p1, p2;
#pragma unroll
                    for (int i = 0; i < 4; ++i) { const float r1 = (fr == 15) ? pm[i] : cur[i], r2 = (fr >= 14) ? pm[i] : cur[i]; p1[i] = __shfl(r1, src1); p2[i] = __shfl(r2, src2); }
                    if (valid && t < 2) {
                        f32x4 h0 = (f32x4){0.f, 0.f, 0.f, 0.f}, h1 = h0;
                        if (samp) { h0 = *(const f32x4*)(st_ffn + ((size_t)sq * 2 + 0) * DFF + j0 + 4 * n); h1 = *(const f32x4*)(st_ffn + ((size_t)sq * 2 + 1) * DFF + j0 + 4 * n); }
                        if (t == 0) { p1 = h1; p2 = h0; } else { p2 = h1; }
                    }
                    const f32x4 gc = w0[n] * p2 + w1[n] * p1 + w2[n] * cur; const f32x4 vv = acc[ai][1][m][n];
                    const float f0 = silu_f(gc[0]) * vv[0], f1 = silu_f(gc[1]) * vv[1], f2 = silu_f(gc[2]) * vv[2], f3 = silu_f(gc[3]) * vv[3];
                    if (n == 0) { pk.x = cvt_pk_bf16(f0, f1); pk.y = cvt_pk_bf16(f2, f3); } else { pk.z = cvt_pk_bf16(f0, f1); pk.w = cvt_pk_bf16(f2, f3); }
                    if (valid && t >= Tseq - 2) { float* d = outb + (samp ? O_NFC_S : O_NFC_P) + ((size_t)sq * 2 + (t - (Tseq - 2))) * DFF + j0 + 4 * n; *(f32x4*)d = cur; }
                }
                if (valid && (samp || t >= 16)) { const int frow = samp ? 16384 + (R - ROWS_P) : sq * 4096 + (t - 16); *(u32x4*)(F + (size_t)frow * DFF + j0) = pk; }
            }
        }
    }
};
}

__device__ __forceinline__ void transpose_item(const float* W, int ldw, int k0, int n0, bf16_t* WT, int K, int drow0, LAS float* scr, int lane) {
#pragma unroll 8
    for (int i = 0; i < 32; ++i) { const int kk = 2 * i + (lane >> 5); scr[kk * 33 + (lane & 31)] = __builtin_nontemporal_load(W + (size_t)(k0 + kk) * ldw + n0 + (lane & 31)); }
    LDS_WAIT();
    const int c = lane & 7;
#pragma unroll
    for (int j = 0; j < 4; ++j) { const int n = (lane >> 3) + 8 * j; const LAS float* s = scr + (8 * c) * 33 + n;
        u32x4 o; o.x = cvt_pk_bf16(s[0 * 33], s[1 * 33]); o.y = cvt_pk_bf16(s[2 * 33], s[3 * 33]); o.z = cvt_pk_bf16(s[4 * 33], s[5 * 33]); o.w = cvt_pk_bf16(s[6 * 33], s[7 * 33]);
        *(u32x4*)(WT + (size_t)(drow0 + n) * K + k0 + 8 * c) = o; }
    LDS_WAIT();
}
__device__ __forceinline__ void transpose_issue(float (&r)[32], const float* W, int ldw, int k0, int n0, int lane) {
#pragma unroll
    for (int i = 0; i < 32; ++i) { const int kk = 2 * i + (lane >> 5); r[i] = __builtin_nontemporal_load(W + (size_t)(k0 + kk) * ldw + n0 + (lane & 31)); }
}
__device__ __forceinline__ void transpose_finish(const float (&r)[32], bf16_t* WT, int K, int k0, int drow0, LAS float* scr, int lane) {
#pragma unroll
    for (int i = 0; i < 32; ++i) { const int kk = 2 * i + (lane >> 5); scr[kk * 33 + (lane & 31)] = r[i]; }
    LDS_WAIT();
    const int c = lane & 7;
#pragma unroll
    for (int j = 0; j < 4; ++j) { const int n = (lane >> 3) + 8 * j; const LAS float* s = scr + (8 * c) * 33 + n;
        u32x4 o; o.x = cvt_pk_bf16(s[0 * 33], s[1 * 33]); o.y = cvt_pk_bf16(s[2 * 33], s[3 * 33]); o.z = cvt_pk_bf16(s[4 * 33], s[5 * 33]); o.w = cvt_pk_bf16(s[6 * 33], s[7 * 33]);
        *(u32x4*)(WT + (size_t)(drow0 + n) * K + k0 + 8 * c) = o; }
    LDS_WAIT();
}
__device__ __forceinline__ void norm_store_bf16(const f32x4 (&v)[8], const float* g, bf16_t* orow, int lane) {
    float s = 0.f;
#pragma unroll
    for (int j = 0; j < 8; ++j) s += (v[j][0] * v[j][0] + v[j][1] * v[j][1]) + (v[j][2] * v[j][2] + v[j][3] * v[j][3]);
    const float r = rsqrtf(wave_sum(s) * (1.f / DM) + EPS);
#pragma unroll
    for (int j = 0; j < 8; ++j) { const f32x4 gg = *(const f32x4*)(g + 4 * lane + 256 * j); const f32x4 o = v[j] * r * gg;
        u32x2 w; w.x = cvt_pk_bf16(o[0], o[1]); w.y = cvt_pk_bf16(o[2], o[3]); *(u32x2*)(orow + 4 * lane + 256 * j) = w; }
}

template <int I> __device__ __forceinline__ void subst_row(float (&x)[64], const LAS float* Mm, float r) {
#pragma unroll
    for (int j4 = 0; j4 < I; j4 += 4) { const f32x4 mv = *(const LAS f32x4*)(Mm + I * 64 + j4);
#pragma unroll
        for (int e = 0; e < 4; ++e) if (j4 + e < I) r -= mv[e] * x[j4 + e]; }
    x[I] = r;
    __builtin_amdgcn_sched_barrier(0);
}
template <int I> struct SubstAll {
    static __device__ __forceinline__ void run(float (&x)[64], const LAS float* Mm, const LAS bf16_t* srcc, const LAS float* scl) {
        SubstAll<I - 1>::run(x, Mm, srcc, scl);
        subst_row<I>(x, Mm, bf2f(srcc[I * 136]) * scl[I]);
    }
};
template <> struct SubstAll<-1> { static __device__ __forceinline__ void run(float (&)[64], const LAS float*, const LAS bf16_t*, const LAS float*) {} };

#define GDN_STEP_BODY(LD8, LD4) \
    bf16x8 Sb[4]; \
    _Pragma("unroll") for (int kb = 0; kb < 4; ++kb) { u32x4 w; w.x = cvt_pk_bf16(S[2 * kb][0], S[2 * kb][1]); w.y = cvt_pk_bf16(S[2 * kb][2], S[2 * kb][3]); w.z = cvt_pk_bf16(S[2 * kb + 1][0], S[2 * kb + 1][1]); w.w = cvt_pk_bf16(S[2 * kb + 1][2], S[2 * kb + 1][3]); \
        Sb[kb] = __builtin_bit_cast(bf16x8, w); } \
    bf16x8 fa[16]; u32x2 ur[4]; \
    _Pragma("unroll") for (int tt = 0; tt < 4; ++tt) { _Pragma("unroll") for (int kb = 0; kb < 4; ++kb) fa[4 * tt + kb] = LD8(Wg + (16 * tt + fr) * 128 + 32 * kb + 8 * fq); ur[tt] = LD4(Us + fr * 64 + 16 * tt + 4 * fq); } \
    f32x4 vn[4]; \
    { f32x4 P[4]; \
      _Pragma("unroll") for (int tt = 0; tt < 4; ++tt) P[tt] = (f32x4){0.f, 0.f, 0.f, 0.f}; \
      _Pragma("unroll") for (int kb = 0; kb < 4; ++kb) _Pragma("unroll") for (int tt = 0; tt < 4; ++tt) P[tt] = __builtin_amdgcn_mfma_f32_16x16x32_bf16(fa[4 * tt + kb], Sb[kb], P[tt], 0, 0, 0); \
      _Pragma("unroll") for (int tt = 0; tt < 4; ++tt) { vn[tt][0] = bflo(ur[tt].x) - P[tt][0]; vn[tt][1] = bfhi(ur[tt].x) - P[tt][1]; vn[tt][2] = bflo(ur[tt].y) - P[tt][2]; vn[tt][3] = bfhi(ur[tt].y) - P[tt][3]; } } \
    _Pragma("unroll") for (int tt = 0; tt < 4; ++tt) _Pragma("unroll") for (int kb = 0; kb < 4; ++kb) fa[4 * tt + kb] = LD8(Wg + 8192 + (16 * tt + fr) * 128 + 32 * kb + 8 * fq); \
    bf16x8 fb[6]; \
    fb[0] = LD8(Wg + 24576 + (fr) * 64 + 8 * fq); fb[1] = LD8(Wg + 24576 + (16 + fr) * 64 + 8 * fq); \
    fb[2] = LD8(Wg + 24576 + (32 + fr) * 64 + 8 * fq); fb[3] = LD8(Wg + 24576 + (32 + fr) * 64 + 32 + 8 * fq); \
    fb[4] = LD8(Wg + 24576 + (48 + fr) * 64 + 8 * fq); fb[5] = LD8(Wg + 24576 + (48 + fr) * 64 + 32 + 8 * fq); \
    bf16x8 Vb2[2]; \
    _Pragma("unroll") for (int k2 = 0; k2 < 2; ++k2) { u32x4 w; w.x = cvt_pk_bf16(vn[2 * k2][0], vn[2 * k2][1]); w.y = cvt_pk_bf16(vn[2 * k2][2], vn[2 * k2][3]); w.z = cvt_pk_bf16(vn[2 * k2 + 1][0], vn[2 * k2 + 1][1]); w.w = cvt_pk_bf16(vn[2 * k2 + 1][2], vn[2 * k2 + 1][3]); \
        Vb2[k2] = __builtin_bit_cast(bf16x8, w); } \
    f32x4 O[4]; \
    _Pragma("unroll") for (int tt = 0; tt < 4; ++tt) O[tt] = (f32x4){0.f, 0.f, 0.f, 0.f}; \
    _Pragma("unroll") for (int kb = 0; kb < 4; ++kb) _Pragma("unroll") for (int tt = 0; tt < 4; ++tt) O[tt] = __builtin_amdgcn_mfma_f32_16x16x32_bf16(fa[4 * tt + kb], Sb[kb], O[tt], 0, 0, 0); \
    O[0] = __builtin_amdgcn_mfma_f32_16x16x32_bf16(fb[0], Vb2[0], O[0], 0, 0, 0); O[1] = __builtin_amdgcn_mfma_f32_16x16x32_bf16(fb[1], Vb2[0], O[1], 0, 0, 0); \
    O[2] = __builtin_amdgcn_mfma_f32_16x16x32_bf16(fb[2], Vb2[0], O[2], 0, 0, 0); O[2] = __builtin_amdgcn_mfma_f32_16x16x32_bf16(fb[3], Vb2[1], O[2], 0, 0, 0); \
    O[3] = __builtin_amdgcn_mfma_f32_16x16x32_bf16(fb[4], Vb2[0], O[3], 0, 0, 0); O[3] = __builtin_amdgcn_mfma_f32_16x16x32_bf16(fb[5], Vb2[1], O[3], 0, 0, 0); \
    _Pragma("unroll") for (int dt = 0; dt < 8; ++dt) _Pragma("unroll") for (int k2 = 0; k2 < 2; ++k2) fa[2 * dt + k2] = LD8(Wg + 16384 + (16 * dt + fr) * 64 + 32 * k2 + 8 * fq); \
    if (tok0 >= 0 && tok0 + 64 <= Tseq) { \
        _Pragma("unroll") for (int tt = 0; tt < 4; ++tt) _Pragma("unroll") for (int jj = 0; jj < 4; ++jj) obase[(size_t)(tok0 + 16 * tt + 4 * fq + jj) * 1024] = O[tt][jj]; \
    } else { \
        _Pragma("unroll") for (int tt = 0; tt < 4; ++tt) _Pragma("unroll") for (int jj = 0; jj < 4; ++jj) { const int tk = tok0 + 16 * tt + 4 * fq + jj; if (tk >= 0 && tk < Tseq) obase[(size_t)tk * 1024] = O[tt][jj]; } \
    } \
    _Pragma("unroll") for (int dt = 0; dt < 8; ++dt) S[dt] = S[dt] * egl; \
    _Pragma("unroll") for (int k2 = 0; k2 < 2; ++k2) _Pragma("unroll") for (int dt = 0; dt < 8; ++dt) S[dt] = __builtin_amdgcn_mfma_f32_16x16x32_bf16(fa[2 * dt + k2], Vb2[k2], S[dt], 0, 0, 0);
__device__ __forceinline__ void gdn_step_lds(f32x4 (&S)[8], const LAS bf16_t* Wg, const LAS bf16_t* Us, float egl, float* obase, int tok0, int Tseq, int fr, int fq) {
#define LD8L(p) (*(const LAS bf16x8*)(p))
#define LD4L(p) (*(const LAS u32x2*)(p))
    GDN_STEP_BODY(LD8L, LD4L)
}
__device__ __forceinline__ void gdn_step_glb(f32x4 (&S)[8], const bf16_t* Wg, const bf16_t* Us, float egl, float* obase, int tok0, int Tseq, int fr, int fq) {
#define LD8G(p) (*(const bf16x8*)(p))
#define LD4G(p) (*(const u32x2*)(p))
    GDN_STEP_BODY(LD8G, LD4G)
}

#define XB_TMO      128
#define XB_XCNT(j)  (256  + 64 * (j))
#define XB_XSUB(j)  (1280 + 64 * (j))
#define XB_XGEN(j)  (2304 + 64 * (j))
#define XB_TOP      3328
#define XB_TOPGEN   3392
#define XCD_BAR_WORDS 3456
#define XB_SPIN_CAP (1u << 22)
__device__ __forceinline__ unsigned xb_ld(unsigned* p)              { return __hip_atomic_load(p, __ATOMIC_RELAXED, __HIP_MEMORY_SCOPE_AGENT); }
__device__ __forceinline__ unsigned xb_add(unsigned* p, unsigned v) { return __hip_atomic_fetch_add(p, v, __ATOMIC_RELAXED, __HIP_MEMORY_SCOPE_AGENT); }
__device__ __forceinline__ unsigned xb_xcc_id() { return (unsigned)__builtin_amdgcn_s_getreg((3 << 11) | 20) & 0xFu; }
#define XB_SPIN(cond, bar) do { unsigned _sp = 0; while (cond) { __builtin_amdgcn_s_sleep(1); \
    if ((++_sp & 255u) == 0u) { if (xb_ld(&(bar)[XB_TMO])) break; if (_sp > XB_SPIN_CAP) { atomicAdd(&(bar)[XB_TMO], 1u); break; } } } } while (0)
struct XcdBarrier { unsigned* bar; unsigned x; volatile LAS unsigned* st; };
__device__ __forceinline__ XcdBarrier xcd_barrier_post(unsigned* bar, volatile LAS unsigned* st) {
    XcdBarrier b; b.bar = bar; b.x = xb_xcc_id(); b.st = st;
    if (threadIdx.x == 0) (void)xb_add(&bar[XB_XCNT(b.x)], 1u);
    return b;
}
__device__ __forceinline__ void xcd_barrier_complete(unsigned* bar, unsigned x, unsigned& nloc, unsigned& nx) {
    const unsigned G = gridDim.x * gridDim.y * gridDim.z;
    unsigned sum, cnt, mine, sp = 0u;
    for (;;) {
        sum = 0u; cnt = 0u; mine = 0u;
#pragma unroll
        for (unsigned j = 0; j < 16; ++j) { const unsigned c = xb_ld(&bar[XB_XCNT(j)]); sum += c; cnt += (c > 0u) ? 1u : 0u; mine = (j == x) ? c : mine; }
        if (sum == G) break;
        __builtin_amdgcn_s_sleep(1);
        if ((++sp & 255u) == 0u) { if (xb_ld(&bar[XB_TMO])) break; if (sp > XB_SPIN_CAP) { atomicAdd(&bar[XB_TMO], 1u); break; } }
    }
    nloc = mine > 0u ? mine : 1u; nx = cnt > 0u ? cnt : 1u;
}
__device__ __forceinline__ void xcd_barrier(const XcdBarrier& b) {
    asm volatile("s_waitcnt vmcnt(0)" ::: "memory");
    __syncthreads();
    if (threadIdx.x == 0) {
        unsigned* bar = b.bar;
        __builtin_amdgcn_s_waitcnt(0);
        unsigned nloc = b.st[0], nx = b.st[1];
        if (nloc == 0u) { xcd_barrier_complete(bar, b.x, nloc, nx); b.st[0] = nloc; b.st[1] = nx; }
        const unsigned old = xb_add(&bar[XB_XSUB(b.x)], 1u);
        const unsigned gen = old / nloc;
        if (old + 1u == (gen + 1u) * nloc) {
            __builtin_amdgcn_fence(__ATOMIC_RELEASE, "agent");
            asm volatile("s_waitcnt vmcnt(0)" ::: "memory");
            const unsigned og = xb_add(&bar[XB_TOP], 1u);
            const unsigned tg = og / nx;
            if (og + 1u == (tg + 1u) * nx) xb_add(&bar[XB_TOPGEN], 1u);
            else XB_SPIN(xb_ld(&bar[XB_TOPGEN]) == tg, bar);
            __builtin_amdgcn_fence(__ATOMIC_ACQUIRE, "agent");
            xb_add(&bar[XB_XGEN(b.x)], 1u);
            asm volatile("s_waitcnt vmcnt(0)" ::: "memory");
        } else {
            XB_SPIN(xb_ld(&bar[XB_XGEN(b.x)]) == gen, bar);
            __builtin_amdgcn_fence(__ATOMIC_ACQUIRE, "agent");
            asm volatile("s_waitcnt vmcnt(0)" ::: "memory");
        }
    }
    __syncthreads();
}

__global__ void __launch_bounds__(512, 2) hymba_fwd(Params p) {
    extern __shared__ __attribute__((aligned(16))) unsigned char lds_raw[];
    LAS unsigned char* lds = (LAS unsigned char*)lds_raw;
    const int G = gridDim.x, bx = blockIdx.x, NGW = G * 8, NGT = G * 512;
#define PHASE_LOCALS int tid = threadIdx.x; asm volatile("" : "+v"(tid)); const int lane = tid & 63, wave = __builtin_amdgcn_readfirstlane(tid >> 6), gw = bx * 8 + wave, gtid = bx * 512 + tid; (void)gw; (void)gtid; (void)lane;
    unsigned char* ws = p.ws;
    bf16_t* Wt_in = (bf16_t*)(ws + WS_WIN); bf16_t* Wt_down = (bf16_t*)(ws + WS_WDOWN); bf16_t* Wt_out = (bf16_t*)(ws + WS_WOUT); bf16_t* Wt_up = (bf16_t*)(ws + WS_WUP);
    bf16_t* Bm = (bf16_t*)(ws + WS_B) + 2 * DM;
    bf16_t* PROJ = (bf16_t*)(ws + WS_C); float* OBUF = (float*)(ws + WS_C); bf16_t* MOb = (bf16_t*)(ws + WS_C); bf16_t* FOb = (bf16_t*)(ws + WS_B); bf16_t* Fb = (bf16_t*)(ws + WS_F);
    bf16_t* Zb = (bf16_t*)(ws + WS_Z); float* AB = (float*)(ws + WS_AB); float* PART = (float*)(ws + WS_PART); float* EGL = (float*)(ws + WS_EGL);
    unsigned char* GDN = ws + WS_GDN; bf16_t* X1 = (bf16_t*)(ws + WS_X1);
    float* out = p.out;
    if (threadIdx.x < 2) ((volatile LAS unsigned*)(lds + LDS_BYTES - 64))[threadIdx.x] = 0u;
    __syncthreads();
    const XcdBarrier xbar = xcd_barrier_post((unsigned*)ws, (volatile LAS unsigned*)(lds + LDS_BYTES - 64));

    PH(0) {
        PHASE_LOCALS
        LAS float* scr = (LAS float*)(lds + wave * 8448);
        constexpr int I_IN = 32 * 224, I_OUT = 32 * 64;
        for (int it = gw; it < I_IN + I_OUT; it += NGW) {
            if (it < I_IN) { const int kb = it / 224, nb = it - kb * 224; transpose_item(p.w_in, INC, 64 * kb, 32 * nb, Wt_in, DM, 32 * nb, scr, lane); }
            else { const int r = it - I_IN, kb = r >> 6, nb = r & 63; transpose_item(p.w_out, DM, 64 * kb, 32 * nb, Wt_out, DM, 32 * nb, scr, lane); }
        }
        for (int idx = gtid; idx < 16 * DM; idx += NGT) { const int n = idx >> 11, k = idx & 2047; Wt_in[(size_t)(7168 + n) * DM + k] = f2bf(p.w_in[(size_t)k * INC + 7168 + n]); }
        for (int idx = gtid; idx < 240 * DM / 8; idx += NGT) ((u32x4*)(Wt_in + (size_t)7184 * DM))[idx] = (u32x4){0u, 0u, 0u, 0u};
        {
            f32x4 nx[8]; const float* xr = x_row(p, gw);
#pragma unroll
            for (int j = 0; j < 8; ++j) nx[j] = xr ? __builtin_nontemporal_load((const f32x4*)(xr + 4 * lane + 256 * j)) : (f32x4){0.f, 0.f, 0.f, 0.f};
#pragma unroll 1
            for (int R = gw; R < T_PAD; R += NGW) {
                f32x4 v[8]; const bool live = xr != nullptr;
#pragma unroll
                for (int j = 0; j < 8; ++j) v[j] = nx[j];
                xr = (R + NGW < T_PAD) ? x_row(p, R + NGW) : nullptr;
                if (xr) {
#pragma unroll
                    for (int j = 0; j < 8; ++j) nx[j] = __builtin_nontemporal_load((const f32x4*)(xr + 4 * lane + 256 * j));
                }
                bf16_t* orow = Bm + (size_t)R * DM;
                if (live) norm_store_bf16(v, p.g_pre_mix, orow, lane);
                else {
#pragma unroll
                    for (int j = 0; j < 8; ++j) *(u32x2*)(orow + 4 * lane + 256 * j) = (u32x2){0u, 0u};
                }
            }
        }
    }
    xcd_barrier(xbar);

    PH(1) {
        PHASE_LOCALS
        pg8::Gemm g{Bm, Wt_in, DM, (size_t)256 * DM * 2}; pg8::StaticOrder S; S.init(65, 29, G, bx);
        pg8::EpiProj E{PROJ, Zb, AB};
        pg8::gemm_phase<pg8::EpiProj>(lds, g, S, E);
    }
    xcd_barrier(xbar);

    PH(2) {
        PHASE_LOCALS
        const int half = tid >> 8, t = tid & 255, hw = wave & 3;
        LAS unsigned char* L = lds + half * 70656;
        LAS bf16_t* Kb = (LAS bf16_t*)L; LAS bf16_t* Qb = (LAS bf16_t*)(L + 17408); LAS bf16_t* Vb = (LAS bf16_t*)(L + 34816);
        LAS float* Mm = (LAS float*)(L + 52224); LAS float* gc = (LAS float*)(L + 68608); LAS float* bt = gc + 64; LAS float* eg = gc + 128; LAS float* bw = gc + 192; LAS float* kdv = gc + 256;
        const int fr = lane & 15, fq = lane >> 4;
        for (int pr = bx; pr < NITEM / 2; pr += G) {
            const int item = 2 * pr + half;
            int h, tok0, Tseq, rowbase, sidx; bool samp;
            if (item < NITEM_P) { const int bh = item / 65, c = item - bh * 65; sidx = bh >> 3; h = bh & 7; tok0 = 64 * c - 48; Tseq = NPT; rowbase = sidx * NPT; samp = false; }
            else { const int sh = item - NITEM_P; sidx = sh >> 3; h = sh & 7; tok0 = 0; Tseq = 16; rowbase = ROWS_P + 16 * sidx; samp = true; }
            unsigned char* blob = GDN + (size_t)item * BLOB;
            bf16_t* Wg = (bf16_t*)blob; bf16_t* QGg = Wg + 8192; bf16_t* KDTg = Wg + 16384; bf16_t* ATTg = Wg + 24576; bf16_t* UTg = Wg + 28672;
            if (t < 64) {
                const int tk = tok0 + t; float gval = 0.f, bval = 0.f;
                if (tk >= 0 && tk < Tseq) { const float* abr = AB + (size_t)(rowbase + tk) * 16; const float bl = abr[h], al = abr[8 + h] + p.dt_bias[h];
                    bval = 1.f / (1.f + __expf(-bl)); const float sp = al > 20.f ? al : log1pf(__expf(al)); gval = -__expf(p.a_log[h]) * sp; }
                float cs = gval;
#pragma unroll
                for (int o = 1; o < 64; o <<= 1) { const float y = __shfl_up(cs, o); if (lane >= o) cs += y; }
                gc[t] = cs; bt[t] = bval; eg[t] = __expf(cs); bw[t] = bval * __expf(cs); kdv[t] = __expf(__shfl(cs, 63) - cs);
            }
            { LAS float* wl = Mm;
#pragma unroll
              for (int i = 0; i < 6; ++i) { const int v = t + 256 * i, j = v / 384, r = v - j * 384; wl[v] = p.w_conv_gdn[(size_t)j * 3072 + (r >> 7) * 1024 + h * 128 + (r & 127)]; } }
            __syncthreads();
            P2(0)
#pragma unroll 1
            for (int ib = 0; ib < 3; ++ib) {
                u32x4 raw[4][4];
#pragma unroll
                for (int u = 0; u < 4; ++u) {
                    const int idx = t + 256 * (4 * ib + u), pp = idx / 48, oct = idx - pp * 48, cq = (oct >> 4) * 1024 + h * 128 + (oct & 15) * 8;
                    const int tk = tok0 + pp;
#pragma unroll
                    for (int j = 0; j < 4; ++j) { int tj = tk - j; tj = tj < 0 ? 0 : (tj >= Tseq ? Tseq - 1 : tj);
                        raw[u][j] = *(const u32x4*)(PROJ + (size_t)(rowbase + tj) * 6144 + 3072 + cq);
}
                }
#pragma unroll
                for (int u = 0; u < 4; ++u) {
                    const int idx = t + 256 * (4 * ib + u), pp = idx / 48, oct = idx - pp * 48, which = oct >> 4, d0 = (oct & 15) * 8, cq = which * 1024 + h * 128 + d0;
                    const int tk = tok0 + pp; const bool valid = (tk >= 0 && tk < Tseq);
                    float y[8];
#pragma unroll
                    for (int e = 0; e < 8; ++e) y[e] = 0.f;
#pragma unroll
                    for (int j = 0; j < 4; ++j) { const float m = (tk - j >= 0) ? 1.f : 0.f; const u32x4 r = raw[u][j]; const LAS float* wlp = Mm + (3 - j) * 384 + which * 128 + d0; const f32x4 wa = *(const LAS f32x4*)wlp * m, wb = *(const LAS f32x4*)(wlp + 4) * m;
                        y[0] += wa[0] * bflo(r.x); y[1] += wa[1] * bfhi(r.x); y[2] += wa[2] * bflo(r.y); y[3] += wa[3] * bfhi(r.y); y[4] += wb[0] * bflo(r.z); y[5] += wb[1] * bfhi(r.z); y[6] += wb[2] * bflo(r.w); y[7] += wb[3] * bfhi(r.w); }
                    if (samp && valid && tk < 3) {
#pragma unroll
                        for (int j = 1; j < 4; ++j) if (tk - j < 0) { const float* hp = p.st_gdn_conv + ((size_t)sidx * 3 + (3 + tk - j)) * 3072 + cq; const f32x4 a = *(const f32x4*)hp, bq = *(const f32x4*)(hp + 4);
                            const LAS float* wlp = Mm + (3 - j) * 384 + which * 128 + d0; const f32x4 wa = *(const LAS f32x4*)wlp, wb = *(const LAS f32x4*)(wlp + 4);
                            y[0] += wa[0] * a[0]; y[1] += wa[1] * a[1]; y[2] += wa[2] * a[2]; y[3] += wa[3] * a[3];
                            y[4] += wb[0] * bq[0]; y[5] += wb[1] * bq[1]; y[6] += wb[2] * bq[2]; y[7] += wb[3] * bq[3]; }
                    }
                    float ss = 0.f;
#pragma unroll
                    for (int e = 0; e < 8; ++e) { y[e] = valid ? silu_f(y[e]) : 0.f; ss += y[e] * y[e]; }
                    ss += __shfl_xor(ss, 1); ss += __shfl_xor(ss, 2); ss += __shfl_xor(ss, 4); ss += __shfl_xor(ss, 8);
                    float sc = 1.f;
                    if (which == 0) sc = rsqrtf(ss + EPS) * 0.08838834764831845f; else if (which == 1) sc = rsqrtf(ss + EPS);
                    u32x4 o; o.x = cvt_pk_bf16(y[0] * sc, y[1] * sc); o.y = cvt_pk_bf16(y[2] * sc, y[3] * sc); o.z = cvt_pk_bf16(y[4] * sc, y[5] * sc); o.w = cvt_pk_bf16(y[6] * sc, y[7] * sc);
                    LAS bf16_t* dst = (which == 0 ? Qb : (which == 1 ? Kb : Vb)) + pp * 136 + d0;
                    *(LAS u32x4*)dst = o;
                }
            }
            __syncthreads();
            P2(1) {
                const int ti = hw, i = 16 * ti + fr; const float gi = gc[i], bi = bt[i];
                bf16x8 ka[4], qa[4];
#pragma unroll
                for (int kb = 0; kb < 4; ++kb) { ka[kb] = *(const LAS bf16x8*)(Kb + i * 136 + kb * 32 + fq * 8); qa[kb] = *(const LAS bf16x8*)(Qb + i * 136 + kb * 32 + fq * 8); }
#pragma unroll 1
                for (int tj = 0; tj <= (ti | 1); ++tj) {
                    f32x4 kk = (f32x4){0.f, 0.f, 0.f, 0.f}, qk = kk;
                    if (tj <= ti) {
#pragma unroll
                        for (int kb = 0; kb < 4; ++kb) { const bf16x8 b = *(const LAS bf16x8*)(Kb + (16 * tj + fr) * 136 + kb * 32 + fq * 8);
                            kk = __builtin_amdgcn_mfma_f32_16x16x32_bf16(b, ka[kb], kk, 0, 0, 0); qk = __builtin_amdgcn_mfma_f32_16x16x32_bf16(b, qa[kb], qk, 0, 0, 0); }
                    }
                    const int jb = 16 * tj + 4 * fq; const f32x4 gj = *(const LAS f32x4*)(gc + jb);
                    f32x4 mrow, arow;
#pragma unroll
                    for (int jj = 0; jj < 4; ++jj) { const int j = jb + jj; const float dec = (i >= j) ? __expf(gi - gj[jj]) : 0.f; mrow[jj] = (i > j) ? bi * kk[jj] * dec : 0.f; arow[jj] = qk[jj] * dec; }
                    if (tj <= ti) *(LAS f32x4*)(Mm + i * 64 + jb) = mrow;
                    u32x2 aw; aw.x = cvt_pk_bf16(arow[0], arow[1]); aw.y = cvt_pk_bf16(arow[2], arow[3]);
                    *(u32x2*)(ATTg + i * 64 + (tj >> 1) * 32 + 8 * fq + 4 * (tj & 1)) = aw;
                }
            }
            P2(2) {
#pragma unroll
                for (int i = 0; i < 4; ++i) { const int v = t + 256 * i, tok = v >> 4, oct = v & 15, dkb = (oct >> 2) * 32 + (oct & 3) * 4; const float e = eg[tok];
                    const u32x2 lo = *(const LAS u32x2*)(Qb + tok * 136 + dkb), hi = *(const LAS u32x2*)(Qb + tok * 136 + dkb + 16);
                    u32x4 o; o.x = cvt_pk_bf16(bflo(lo.x) * e, bfhi(lo.x) * e); o.y = cvt_pk_bf16(bflo(lo.y) * e, bfhi(lo.y) * e); o.z = cvt_pk_bf16(bflo(hi.x) * e, bfhi(hi.x) * e); o.w = cvt_pk_bf16(bflo(hi.y) * e, bfhi(hi.y) * e);
                    *(u32x4*)(QGg + tok * 128 + 8 * oct) = o; }
#pragma unroll
                for (int i = 0; i < 4; ++i) { const int v = t + 256 * i, dk = v >> 3, oct = v & 7, tb = (oct >> 2) * 32 + (oct & 3) * 4; float f[8];
#pragma unroll
                    for (int e = 0; e < 8; ++e) { const int tok = tb + (e >> 2) * 16 + (e & 3); f[e] = bf2f(Kb[tok * 136 + dk]) * kdv[tok]; }
                    u32x4 o; o.x = cvt_pk_bf16(f[0], f[1]); o.y = cvt_pk_bf16(f[2], f[3]); o.z = cvt_pk_bf16(f[4], f[5]); o.w = cvt_pk_bf16(f[6], f[7]);
                    *(u32x4*)(KDTg + dk * 64 + 8 * oct) = o; }
                if (t == 0) { const float e63 = eg[63]; EGL[item] = e63; *(f32x4*)(blob + 73728) = (f32x4){e63, e63, e63, e63}; }
            }
            __syncthreads();
            P2(3) {
                float x[64];
                const bool isU = t < 128; const int c = t & 127; const LAS bf16_t* src = isU ? Vb : Kb;
                SubstAll<63>::run(x, Mm, src + c, isU ? bt : bw);
                if (isU) {
#pragma unroll
                    for (int q = 0; q < 8; ++q) { u32x4 o; o.x = cvt_pk_bf16(x[8 * q], x[8 * q + 1]); o.y = cvt_pk_bf16(x[8 * q + 2], x[8 * q + 3]); o.z = cvt_pk_bf16(x[8 * q + 4], x[8 * q + 5]); o.w = cvt_pk_bf16(x[8 * q + 6], x[8 * q + 7]);
                        *(u32x4*)(UTg + c * 64 + 8 * q) = o; }
                } else { const int pc = (c & 96) + perm32(c & 31);
#pragma unroll
                    for (int i = 0; i < 64; ++i) Qb[i * 136 + pc] = f2bf(x[i]); }
            }
            __syncthreads();
#pragma unroll
            for (int i = 0; i < 4; ++i) { const int v = t + 256 * i, row = v >> 4, oct = v & 15; *(u32x4*)(Wg + row * 128 + 8 * oct) = *(const LAS u32x4*)(Qb + row * 136 + 8 * oct); }
            __syncthreads();
        }
        P2(4) if (bx >= 48) for (int grp = (bx - 48) * 8 + wave; grp < ROWS_V / 8; grp += (G - 48) * 8) {
            const int R0 = grp * 8; int sq, t0, Tseq; bool samp;
            if (R0 < ROWS_P) { sq = R0 / NPT; t0 = R0 - sq * NPT; Tseq = NPT; samp = false; } else { sq = (R0 - ROWS_P) >> 4; t0 = (R0 - ROWS_P) & 15; Tseq = 16; samp = true; }
            const int c0 = lane * 16;
            float cm1[16], cm2[16], wa0[16], wa1[16], wa2[16], gna[16];
#pragma unroll
            for (int q = 0; q < 4; ++q) { const f32x4 a0 = *(const f32x4*)(p.w_conv_a + c0 + 4 * q), a1 = *(const f32x4*)(p.w_conv_a + 1024 + c0 + 4 * q), a2 = *(const f32x4*)(p.w_conv_a + 2048 + c0 + 4 * q), gg = *(const f32x4*)(p.g_norm_a + c0 + 4 * q);
#pragma unroll
                for (int e = 0; e < 4; ++e) { wa0[4 * q + e] = a0[e]; wa1[4 * q + e] = a1[e]; wa2[4 * q + e] = a2[e]; gna[4 * q + e] = gg[e]; } }
            if (t0 == 0) {
#pragma unroll
                for (int e = 0; e < 16; ++e) { cm2[e] = samp ? p.st_conv_a[((size_t)sq * 2 + 0) * 1024 + c0 + e] : 0.f; cm1[e] = samp ? p.st_conv_a[((size_t)sq * 2 + 1) * 1024 + c0 + e] : 0.f; }
            } else {
#pragma unroll
                for (int k = 0; k < 2; ++k) { const bf16_t* rp = PROJ + (size_t)(R0 - 2 + k) * 6144 + c0;
#pragma unroll
                    for (int q = 0; q < 2; ++q) { const u32x4 ah = *(const u32x4*)(rp + 8 * q), ac = *(const u32x4*)(rp + 1024 + 8 * q); float d[8];
                        d[0] = bflo(ah.x) * bflo(ac.x); d[1] = bfhi(ah.x) * bfhi(ac.x); d[2] = bflo(ah.y) * bflo(ac.y); d[3] = bfhi(ah.y) * bfhi(ac.y);
                        d[4] = bflo(ah.z) * bflo(ac.z); d[5] = bfhi(ah.z) * bfhi(ac.z); d[6] = bflo(ah.w) * bflo(ac.w); d[7] = bfhi(ah.w) * bfhi(ac.w);
#pragma unroll
                        for (int e = 0; e < 8; ++e) { if (k == 0) cm2[8 * q + e] = d[e]; else cm1[8 * q + e] = d[e]; } } }
            }
            u32x4 nx[6];
            { const bf16_t* rp = PROJ + (size_t)R0 * 6144 + c0;
#pragma unroll
              for (int q = 0; q < 2; ++q) { nx[3 * q] = *(const u32x4*)(rp + 8 * q); nx[3 * q + 1] = *(const u32x4*)(rp + 1024 + 8 * q); nx[3 * q + 2] = *(const u32x4*)(rp + 2048 + 8 * q); } }
#pragma unroll 1
            for (int r = 0; r < 8; ++r) {
                const int R = R0 + r, tt = t0 + r;
                u32x4 cu[6];
#pragma unroll
                for (int q = 0; q < 6; ++q) cu[q] = nx[q];
                if (r < 7) { const bf16_t* rp = PROJ + (size_t)(R + 1) * 6144 + c0;
#pragma unroll
                    for (int q = 0; q < 2; ++q) { nx[3 * q] = *(const u32x4*)(rp + 8 * q); nx[3 * q + 1] = *(const u32x4*)(rp + 1024 + 8 * q); nx[3 * q + 2] = *(const u32x4*)(rp + 2048 + 8 * q); } }
                float ca[16], v[16]; float ss = 0.f;
#pragma unroll
                for (int q = 0; q < 2; ++q) { const u32x4 ah = cu[3 * q], ac = cu[3 * q + 1], ab = cu[3 * q + 2]; float* d = ca + 8 * q; float bb[8];
                    d[0] = bflo(ah.x) * bflo(ac.x); d[1] = bfhi(ah.x) * bfhi(ac.x); d[2] = bflo(ah.y) * bflo(ac.y); d[3] = bfhi(ah.y) * bfhi(ac.y);
                    d[4] = bflo(ah.z) * bflo(ac.z); d[5] = bfhi(ah.z) * bfhi(ac.z); d[6] = bflo(ah.w) * bflo(ac.w); d[7] = bfhi(ah.w) * bfhi(ac.w);
                    bb[0] = bflo(ab.x); bb[1] = bfhi(ab.x); bb[2] = bflo(ab.y); bb[3] = bfhi(ab.y); bb[4] = bflo(ab.z); bb[5] = bfhi(ab.z); bb[6] = bflo(ab.w); bb[7] = bfhi(ab.w);
#pragma unroll
                    for (int e = 0; e < 8; ++e) { const float yv = wa2[8 * q + e] * d[e] + wa1[8 * q + e] * cm1[8 * q + e] + wa0[8 * q + e] * cm2[8 * q + e];
                        v[8 * q + e] = bb[e] * yv; ss += v[8 * q + e] * v[8 * q + e]; } }
                const float rn = rsqrtf(wave_sum(ss) * (1.f / 1024.f) + EPS);
                bf16_t* mrow = Bm + (size_t)mu_row(R) * DM + c0;
#pragma unroll
                for (int q = 0; q < 2; ++q) { float o[8];
#pragma unroll
                    for (int e = 0; e < 8; ++e) o[e] = v[8 * q + e] * rn * gna[8 * q + e];
                    u32x4 w; w.x = cvt_pk_bf16(o[0], o[1]); w.y = cvt_pk_bf16(o[2], o[3]); w.z = cvt_pk_bf16(o[4], o[5]); w.w = cvt_pk_bf16(o[6], o[7]);
                    *(u32x4*)(mrow + 8 * q) = w; }
                if (tt >= Tseq - 2) { float* d = out + (samp ? O_NCA_S : O_NCA_P) + ((size_t)sq * 2 + (tt - (Tseq - 2))) * 1024 + c0;
#pragma unroll
                    for (int e = 0; e < 16; ++e) d[e] = ca[e]; }
#pragma unroll
                for (int e = 0; e < 16; ++e) { cm2[e] = cm1[e]; cm1[e] = ca[e]; }
            }
        }
        for (int idx = gtid; idx < 12 * 3 * 3072; idx += NGT) {
            const int col = idx % 3072, r = (idx / 3072) % 3, sq = idx / 9216;
            if (sq < 4) out[O_NGC_P + ((size_t)sq * 3 + r) * 3072 + col] = bf2f(PROJ[(size_t)(sq * NPT + NPT - 3 + r) * 6144 + 3072 + col]);
            else out[O_NGC_S + ((size_t)(sq - 4) * 3 + r) * 3072 + col] = bf2f(PROJ[(size_t)(ROWS_P + (sq - 4) * 16 + 13 + r) * 6144 + 3072 + col]);
        }
    }
    xcd_barrier(xbar);

    PH(3) {
        PHASE_LOCALS
        const int fr = lane & 15, fq = lane >> 4;
        constexpr int RB = 59408;
        if (bx < 256) {
            const int x = bx & 7, y = bx >> 3, bh = x * 4 + (y >> 3), sl = y & 7, sidx = bh >> 3, h = bh & 7, item0 = bh * 65, dv0 = 16 * sl, rowbase = sidx * NPT;
            f32x4 S[8];
#pragma unroll
            for (int dt = 0; dt < 8; ++dt) S[dt] = (f32x4){0.f, 0.f, 0.f, 0.f};
            u32x4 stgA[12], stgB[12];
            const int lt = tid - 64;
#define P3_ISSUE(stg, eg, c) do { const unsigned char* bsrc = GDN + (size_t)(item0 + (c)) * BLOB; _Pragma("unroll") for (int k = 0; k < 12; ++k) { int i = lt + 320 * k; i = i > 3712 ? 3712 : i; \
                const int so = i < 3584 ? i * 16 : (i < 3712 ? 57344 + dv0 * 128 + (i - 3584) * 16 : 73728); stg[k] = *(const u32x4*)(bsrc + so); } } while (0)
#define P3_WRITE(stg, eg, c) do { LAS unsigned char* bdst = lds + ((c) & 1) * RB; _Pragma("unroll") for (int k = 0; k < 12; ++k) { int i = lt + 320 * k; i = i > 3712 ? 3712 : i; *(LAS u32x4*)(bdst + i * 16) = stg[k]; } } while (0)
#define P3_BAR() do { asm volatile("s_waitcnt lgkmcnt(0)" ::: "memory"); __builtin_amdgcn_s_barrier(); asm volatile("" ::: "memory"); } while (0)
#define P3_COMPUTE(c) do { const LAS bf16_t* Wl = (const LAS bf16_t*)(lds + ((c) & 1) * RB); \
                gdn_step_lds(S, Wl, Wl + 28672, *(const LAS float*)(Wl + 29696), OBUF + (size_t)rowbase * 1024 + h * 128 + dv0 + fr, 64 * (c) - 48, NPT, fr, fq); } while (0)
            if (wave == 0) {
                P3_BAR();
#pragma unroll 1
                for (int c = 0; c < 65; ++c) { P3_COMPUTE(c); P3_BAR(); }
            } else if (wave < 6) {
                P3_ISSUE(stgB, 0, 0); P3_ISSUE(stgA, 0, 1); P3_WRITE(stgB, 0, 0); P3_ISSUE(stgB, 0, 2);
                P3_BAR();
#pragma unroll 1
                for (int c = 0; c < 64; c += 2) {
                    P3_WRITE(stgA, 0, c + 1); if (c + 3 < 65) P3_ISSUE(stgA, 0, c + 3);
                    P3_BAR();
                    P3_WRITE(stgB, 0, c + 2); if (c + 4 < 65) P3_ISSUE(stgB, 0, c + 4);
                    P3_BAR();
                }
                P3_BAR();
            } else {
                constexpr int I_UP = 32 * 352, I_DN = 88 * 64;
                LAS float* scr = (LAS float*)(lds + 2 * RB + (wave - 6) * 8448);
                const int sw = bx * 2 + (wave - 6);
                float tr[32];
#define P3_TR_ISSUE(it) do { if ((it) < I_UP) { const int kb = (it) / 352, nb = (it) - kb * 352; transpose_issue(tr, p.w_up, 2 * DFF, 64 * kb, 32 * nb, lane); } \
                    else { const int r_ = (it) - I_UP, kb = r_ >> 6, nb = r_ & 63; transpose_issue(tr, p.w_down, DM, 64 * kb, 32 * nb, lane); } } while (0)
#define P3_TR_FINISH(it) do { if ((it) < I_UP) { const int kb = (it) / 352, nb = (it) - kb * 352, n0 = 32 * nb; const int j_ = n0 < DFF ? n0 : n0 - DFF; const int drow = 256 * (j_ >> 7) + (n0 < DFF ? 0 : 128) + (j_ & 127); \
                        transpose_finish(tr, Wt_up, DM, 64 * kb, drow, scr, lane); } \
                    else { const int r_ = (it) - I_UP, kb = r_ >> 6, nb = r_ & 63; transpose_finish(tr, Wt_down, DFF, 64 * kb, 32 * nb, scr, lane); } } while (0)
                int it = sw;
                if (it < I_UP + I_DN) P3_TR_ISSUE(it);
                P3_BAR();
#pragma unroll 1
                for (int c = 0; c < 65; ++c) {
                    if (it < I_UP + I_DN) { P3_TR_FINISH(it); it += 512; if (it < I_UP + I_DN) P3_TR_ISSUE(it); }
                    P3_BAR();
                }
#pragma unroll 1
                while (it < I_UP + I_DN) { P3_TR_FINISH(it); it += 512; if (it < I_UP + I_DN) P3_TR_ISSUE(it); }
            }
            if (wave == 0) {
                float* sd = out + O_NGD_P + ((size_t)sidx * 8 + h) * 16384;
#pragma unroll
                for (int dt = 0; dt < 8; ++dt)
#pragma unroll
                    for (int jj = 0; jj < 4; ++jj) sd[(16 * dt + 4 * fq + jj) * 128 + dv0 + fr] = S[dt][jj];
            }
        }
        if (wave < 2) {
            const int w = 2 * bx + wave;
            if (w < 512) {
                const int sh = w >> 3, sl = w & 7, sidx = sh >> 3, h = sh & 7, dv0 = 16 * sl, item = NITEM_P + sh;
                f32x4 S[8];
#pragma unroll
                for (int dt = 0; dt < 8; ++dt)
#pragma unroll
                    for (int jj = 0; jj < 4; ++jj) S[dt][jj] = p.st_gdn[(((size_t)sidx * 8 + h) * 128 + 16 * dt + 4 * fq + jj) * 128 + dv0 + fr];
                const bf16_t* Wg = (const bf16_t*)(GDN + (size_t)item * BLOB);
                gdn_step_glb(S, Wg, Wg + 28672 + dv0 * 64, EGL[item], OBUF + (size_t)(ROWS_P + sidx * 16) * 1024 + h * 128 + dv0 + fr, 0, 16, fr, fq);
                float* sd = out + O_NGD_S + ((size_t)sidx * 8 + h) * 16384;
#pragma unroll
                for (int dt = 0; dt < 8; ++dt)
#pragma unroll
                    for (int jj = 0; jj < 4; ++jj) sd[(16 * dt + 4 * fq + jj) * 128 + dv0 + fr] = S[dt][jj];
            }
        }
    }
    xcd_barrier(xbar);

    PH(4) {
        PHASE_LOCALS
        for (int R = gw; R < ROWS_V; R += NGW) {
            const int hh = lane >> 3, e0 = (lane & 7) * 16; const float* op = OBUF + (size_t)R * 1024 + hh * 128 + e0;
            f32x4 o[4]; float ss = 0.f;
#pragma unroll
            for (int q = 0; q < 4; ++q) { o[q] = *(const f32x4*)(op + 4 * q); ss += (o[q][0] * o[q][0] + o[q][1] * o[q][1]) + (o[q][2] * o[q][2] + o[q][3] * o[q][3]); }
            ss += __shfl_xor(ss, 1); ss += __shfl_xor(ss, 2); ss += __shfl_xor(ss, 4);
            const float rn = rsqrtf(ss * (1.f / 128.f) + EPS);
            const bf16_t* zp = Zb + (size_t)R * 1024 + hh * 128 + e0;
#pragma unroll
            for (int q = 0; q < 2; ++q) { const u32x4 zr = *(const u32x4*)(zp + 8 * q); float zz[8] = {bflo(zr.x), bfhi(zr.x), bflo(zr.y), bfhi(zr.y), bflo(zr.z), bfhi(zr.z), bflo(zr.w), bfhi(zr.w)}; float y[8];
#pragma unroll
                for (int e = 0; e < 8; ++e) y[e] = o[2 * q + (e >> 2)][e & 3] * rn * p.g_norm_gdn[e0 + 8 * q + e] * silu_f(zz[e]);
                u32x4 w; w.x = cvt_pk_bf16(y[0], y[1]); w.y = cvt_pk_bf16(y[2], y[3]); w.z = cvt_pk_bf16(y[4], y[5]); w.w = cvt_pk_bf16(y[6], y[7]);
                *(u32x4*)(Bm + (size_t)mu_row(R) * DM + 1024 + hh * 128 + e0 + 8 * q) = w; }
        }
    }
    xcd_barrier(xbar);

    PH(5) {
        PHASE_LOCALS
        pg8::Gemm g{Bm, Wt_out, DM, (size_t)256 * DM * 2}; pg8::StaticOrder S; S.init(64, 8, G, bx);
        pg8::EpiBf16Part E{MOb, PART};
        pg8::gemm_phase<pg8::EpiBf16Part>(lds, g, S, E);
        const int fr = lane & 15, fq = lane >> 4;
        for (int job = bx; job < 12 * 32; job += G) {
            const int rt = job % 12, cgp = job / 12;
            const bf16_t* ap = Bm + (size_t)(16384 + 16 * rt + fr) * DM + 8 * fq + wave * 256;
            const bf16_t* bp = Wt_out + (size_t)(64 * cgp + fr) * DM + 8 * fq + wave * 256;
            f32x4 acc[4];
#pragma unroll
            for (int n = 0; n < 4; ++n) acc[n] = (f32x4){0.f, 0.f, 0.f, 0.f};
#pragma unroll 2
            for (int ks = 0; ks < 8; ++ks) { const bf16x8 a = *(const bf16x8*)(ap + 32 * ks);
#pragma unroll
                for (int n = 0; n < 4; ++n) { const bf16x8 b = *(const bf16x8*)(bp + (size_t)16 * n * DM + 32 * ks); acc[n] = __builtin_amdgcn_mfma_f32_16x16x32_bf16(b, a, acc[n], 0, 0, 0); } }
            LAS f32x4* red = (LAS f32x4*)lds;
            __syncthreads();
#pragma unroll
            for (int n = 0; n < 4; ++n) red[(wave * 4 + n) * 64 + lane] = acc[n];
            __syncthreads();
            if (wave == 0) {
                float ss = 0.f; const int q = 16384 + 16 * rt + fr;
#pragma unroll
                for (int n = 0; n < 4; ++n) { f32x4 v = red[n * 64 + lane];
#pragma unroll
                    for (int w2 = 1; w2 < 8; ++w2) v += red[(w2 * 4 + n) * 64 + lane];
                    ss += (v[0] * v[0] + v[1] * v[1]) + (v[2] * v[2] + v[3] * v[3]);
                    u32x2 w; w.x = cvt_pk_bf16(v[0], v[1]); w.y = cvt_pk_bf16(v[2], v[3]); *(u32x2*)(MOb + (size_t)q * DM + 64 * cgp + 16 * n + 4 * fq) = w; }
                ss += __shfl_xor(ss, 16); ss += __shfl_xor(ss, 32);
                if (fq == 0) PART[(size_t)q * 32 + cgp] = ss;
            }
        }
    }
    xcd_barrier(xbar);

    PH(6) {
        PHASE_LOCALS
        {
            f32x4 nx[8]; u32x2 nm[8]; float nps = 0.f;
            const float* xr = x_row(p, gw - 2);
            if (xr) { const int mr = mu_row(gw - 2); nps = (lane < 32) ? PART[(size_t)mr * 32 + lane] : 0.f;
#pragma unroll
                for (int j = 0; j < 8; ++j) { const int c = 4 * lane + 256 * j; nx[j] = __builtin_nontemporal_load((const f32x4*)(xr + c)); nm[j] = *(const u32x2*)(MOb + (size_t)mr * DM + c); } }
#pragma unroll 1
            for (int R = gw - 2; R < 16768; R += NGW) {
                const bool live = xr != nullptr; f32x4 xv[8]; u32x2 mv2[8]; float ps = nps;
#pragma unroll
                for (int j = 0; j < 8; ++j) { xv[j] = nx[j]; mv2[j] = nm[j]; }
                const int Rn = R + NGW; xr = (Rn < 16768) ? x_row(p, Rn) : nullptr;
                if (xr) { const int mr = mu_row(Rn); nps = (lane < 32) ? PART[(size_t)mr * 32 + lane] : 0.f;
#pragma unroll
                    for (int j = 0; j < 8; ++j) { const int c = 4 * lane + 256 * j; nx[j] = __builtin_nontemporal_load((const f32x4*)(xr + c)); nm[j] = *(const u32x2*)(MOb + (size_t)mr * DM + c); } }
                bf16_t* orow = Bm + (size_t)R * DM;
                if (live) {
                    ps = wave_sum(ps);
                    const float rn = rsqrtf(ps * (1.f / DM) + EPS);
                    f32x4 v[8];
#pragma unroll
                    for (int j = 0; j < 8; ++j) { const int c = 4 * lane + 256 * j; const f32x4 gg = *(const f32x4*)(p.g_post_mix + c); const f32x4 mv = (f32x4){bflo(mv2[j].x), bfhi(mv2[j].x), bflo(mv2[j].y), bfhi(mv2[j].y)};
                        v[j] = xv[j] + mv * rn * gg; u32x2 xw; xw.x = cvt_pk_bf16(v[j][0], v[j][1]); xw.y = cvt_pk_bf16(v[j][2], v[j][3]); *(u32x2*)(X1 + (size_t)R * DM + c) = xw; }
                    norm_store_bf16(v, p.g_pre_ffn, orow, lane);
                } else {
#pragma unroll
                    for (int j = 0; j < 8; ++j) *(u32x2*)(orow + 4 * lane + 256 * j) = (u32x2){0u, 0u};
                }
            }
        }
    }
    xcd_barrier(xbar);

    PH(7) {
        PHASE_LOCALS
        pg8::Gemm g{Bm - 2 * DM, Wt_up, DM, (size_t)254 * DM * 2}; pg8::StaticOrder S; S.init(66, 44, G, bx);
        pg8::EpiGate E{Fb, p.w_conv_ffn, p.st_ffn_conv, out, (LAS float*)(lds + pg8::STAGE_BYTES)};
        pg8::gemm_phase<pg8::EpiGate>(lds, g, S, E);
    }
    xcd_barrier(xbar);

    PH(9) {
        PHASE_LOCALS
        pg8::Gemm g{Fb, Wt_down, DFF, (size_t)256 * DFF * 2}; pg8::PanelOrder S{bx};
        pg8::EpiFinal E{out + O_YP, X1, p.g_post_ffn, (float*)(ws + 512 * 1024), (unsigned*)ws + 8192, (LAS float*)(lds + pg8::STAGE_BYTES)};
        if (G == 256) pg8::gemm_phase<pg8::EpiFinal, pg8::PanelOrder>(lds, g, S, E);
        if (bx < 256) {
            const int fr = lane & 15, fq = lane >> 4, rt = bx & 7, cgp = bx >> 3;
            const bf16_t* ap = Fb + (size_t)(16384 + 16 * rt + fr) * DFF + 8 * fq + wave * 704;
            const bf16_t* bp = Wt_down + (size_t)(64 * cgp + fr) * DFF + 8 * fq + wave * 704;
            f32x4 acc[4];
#pragma unroll
            for (int n = 0; n < 4; ++n) acc[n] = (f32x4){0.f, 0.f, 0.f, 0.f};
#pragma unroll 2
            for (int ks = 0; ks < 22; ++ks) { const bf16x8 a = *(const bf16x8*)(ap + 32 * ks);
#pragma unroll
                for (int n = 0; n < 4; ++n) { const bf16x8 b = *(const bf16x8*)(bp + (size_t)16 * n * DFF + 32 * ks); acc[n] = __builtin_amdgcn_mfma_f32_16x16x32_bf16(b, a, acc[n], 0, 0, 0); } }
            LAS f32x4* red = (LAS f32x4*)lds;
#pragma unroll
            for (int n = 0; n < 4; ++n) red[(wave * 4 + n) * 64 + lane] = acc[n];
            __syncthreads();
            if (wave == 0) {
                float ss = 0.f; const int q = 16384 + 16 * rt + fr;
#pragma unroll
                for (int n = 0; n < 4; ++n) { f32x4 v = red[n * 64 + lane];
#pragma unroll
                    for (int w2 = 1; w2 < 8; ++w2) v += red[(w2 * 4 + n) * 64 + lane];
                    ss += (v[0] * v[0] + v[1] * v[1]) + (v[2] * v[2] + v[3] * v[3]);
                    u32x2 w; w.x = cvt_pk_bf16(v[0], v[1]); w.y = cvt_pk_bf16(v[2], v[3]); *(u32x2*)(FOb + (size_t)q * DM + 64 * cgp + 16 * n + 4 * fq) = w; }
                ss += __shfl_xor(ss, 16); ss += __shfl_xor(ss, 32);
                if (fq == 0) PART[(size_t)q * 32 + cgp] = ss;
            }
        }
    }
    xcd_barrier(xbar);

    PH(10) {
        PHASE_LOCALS
        for (int q = 16384 + gw; q < 16384 + 128; q += NGW) {
            int R; float* yrow;
            if (q < 16384) { const int b = q >> 12, t = q & 4095; R = b * NPT + 16 + t; yrow = out + O_YP + (size_t)q * DM; } else { R = ROWS_P + (q - 16384); yrow = out + O_YS + (size_t)(q - 16384) * DM; }
            float ps = (lane < 32) ? PART[(size_t)q * 32 + lane] : 0.f; ps = wave_sum(ps);
            const float rn = rsqrtf(ps * (1.f / DM) + EPS);
#pragma unroll
            for (int j = 0; j < 8; ++j) { const int c = 4 * lane + 256 * j; const f32x4 gg = *(const f32x4*)(p.g_post_ffn + c); const u32x2 fr2 = *(const u32x2*)(FOb + (size_t)q * DM + c); const f32x4 fv = (f32x4){bflo(fr2.x), bfhi(fr2.x), bflo(fr2.y), bfhi(fr2.y)}; const u32x2 xr2 = *(const u32x2*)(X1 + (size_t)R * DM + c); const f32x4 xv = (f32x4){bflo(xr2.x), bfhi(xr2.x), bflo(xr2.y), bfhi(xr2.y)};
                *(f32x4*)(yrow + c) = xv + fv * rn * gg; }
        }
    }
}

extern "C" void kernel_launch(void* const* d_in, const int* in_sizes, int n_in, void* d_out, int out_size, void* d_ws, size_t ws_size, hipStream_t stream) {
    static int grid = 0;
    if (grid == 0) {
        if (n_in != 22 || (size_t)out_size != O_END || ws_size < WS_END) { fprintf(stderr, "kernel_launch: unexpected shapes: n_in %d out %d ws %zu\n", n_in, out_size, ws_size); grid = -1; return; }
        int dev = 0, cus = 0, per_cu = 0;
        hipGetDevice(&dev); hipDeviceGetAttribute(&cus, hipDeviceAttributeMultiprocessorCount, dev);
        hipFuncSetAttribute((const void*)hymba_fwd, hipFuncAttributeMaxDynamicSharedMemorySize, LDS_BYTES);
        hipOccupancyMaxActiveBlocksPerMultiprocessor(&per_cu, (const void*)hymba_fwd, 512, LDS_BYTES);
        if (per_cu < 1) { fprintf(stderr, "kernel_launch: occupancy query says %d blocks per CU\n", per_cu); per_cu = 1; }
        grid = cus;
        (void)hipGetLastError();
    }
    if (grid < 0) return;
    (void)hipMemsetAsync(d_ws, 0, 65536, stream);
    Params p{};
    const float** pp = (const float**)&p;
    for (int i = 0; i < 22; ++i) pp[i] = (const float*)d_in[i];
    p.out = (float*)d_out; p.ws = (unsigned char*)d_ws;
    void* args[] = {&p};
    hipError_t e = hipLaunchCooperativeKernel((const void*)hymba_fwd, dim3(grid), dim3(512), args, LDS_BYTES, stream);
    if (e != hipSuccess) fprintf(stderr, "cooperative launch failed: %s (grid %d)\n", hipGetErrorString(e), grid);
}
```

```cpp
#include <hip/hip_runtime.h>
#include <hip/hip_cooperative_groups.h>
#include <cstdio>
#include <cstdint>
namespace cg = cooperative_groups;

#define LAS __attribute__((address_space(3)))
typedef unsigned short bf16_t;
typedef short bf16x8 __attribute__((ext_vector_type(8)));
typedef float f32x4 __attribute__((ext_vector_type(4)));
typedef unsigned u32x4 __attribute__((ext_vector_type(4)));
typedef unsigned u32x2 __attribute__((ext_vector_type(2)));

constexpr int DM = 2048, NPT = 4112  , ROWS_P = 4 * NPT  , ROWS_V = ROWS_P + 128  , T_PAD = 16640;
constexpr int DFF = 5632, INC = 7184;
constexpr int NITEM_P = 4 * 8 * 65, NITEM = NITEM_P + 64;
constexpr float EPS = 1e-6f;
constexpr size_t O_YP = 0, O_YS = 33554432, O_NCA_P = 33816576, O_NGC_P = 33824768, O_NGD_P = 33861632, O_NFC_P = 34385920,
                 O_NCA_S = 34430976, O_NGC_S = 34447360, O_NGD_S = 34521088, O_NFC_S = 35569664, O_END = 35659776;
constexpr size_t MiB = 1u << 20;
constexpr size_t WS_PART = 1 * MiB;
constexpr size_t WS_EGL = 3 * MiB + 512 * 1024;
constexpr size_t WS_WIN = 4 * MiB;
constexpr size_t WS_WDOWN = 4 * MiB;
constexpr size_t WS_WOUT = 33 * MiB;
constexpr size_t WS_B = 41 * MiB;
constexpr size_t WS_C = 107 * MiB;
constexpr size_t WS_Z = 302 * MiB;
constexpr size_t WS_AB = 334 * MiB + 768 * 1024;
constexpr size_t WS_GDN = 336 * MiB;
constexpr size_t WS_X1 = 445 * MiB;
constexpr size_t WS_WUP = 172 * MiB;
constexpr size_t WS_F = 216 * MiB;
constexpr size_t WS_END = 510 * MiB;
constexpr size_t BLOB = 73984;
static_assert(WS_Z + (size_t)T_PAD * 2048 <= WS_AB && WS_AB + (size_t)T_PAD * 64 <= WS_GDN && WS_GDN + (size_t)NITEM * BLOB <= 488 * MiB && WS_PART + (size_t)T_PAD * 128 <= WS_EGL, "ws map");
constexpr int LDS_BYTES = 147456;
#ifndef PHASE_MASK
#define PHASE_MASK 0xFFFF
#endif
#ifndef P2MASK
#define P2MASK 0xFF
#endif
#define P2(n) if constexpr (((P2MASK) >> (n)) & 1)
#ifndef REPEAT_MASK
#define REPEAT_MASK 0
#endif
#ifndef EXTRA_SYNCS
#define EXTRA_SYNCS 0
#endif
#define PH(n) if constexpr (((PHASE_MASK) >> (n)) & 1)

__device__ __forceinline__ unsigned cvt_pk_bf16(float lo, float hi) { unsigned r; asm volatile("v_cvt_pk_bf16_f32 %0, %1, %2" : "=v"(r) : "v"(lo), "v"(hi)); return r; }
__device__ __forceinline__ unsigned short f2bf(float f) { return (unsigned short)(cvt_pk_bf16(f, 0.f) & 0xffffu); }
__device__ __forceinline__ float bf2f(unsigned short b) { return __uint_as_float((unsigned)b << 16); }
__device__ __forceinline__ float bflo(unsigned w) { return __uint_as_float(w << 16); }
__device__ __forceinline__ float bfhi(unsigned w) { return __uint_as_float(w & 0xffff0000u); }
__device__ __forceinline__ float wave_sum(float v) {
#pragma unroll
    for (int o = 1; o < 64; o <<= 1) v += __shfl_xor(v, o);
    return v;
}
__device__ __forceinline__ float silu_f(float x) { return x * __builtin_amdgcn_rcpf(1.f + __expf(-x)); }
__device__ __forceinline__ int perm32(int k) { return ((k >> 2) & 3) * 8 + ((k >> 4) & 1) * 4 + (k & 3); }
#define LDS_WAIT() asm volatile("s_waitcnt lgkmcnt(0)" ::: "memory")

struct Params {
    const float *xp, *xs, *st_conv_a, *st_gdn_conv, *st_gdn, *st_ffn_conv, *meta, *g_pre_mix, *w_in, *w_conv_a, *g_norm_a, *w_conv_gdn,
                *a_log, *dt_bias, *g_norm_gdn, *w_out, *g_post_mix, *g_pre_ffn, *w_up, *w_conv_ffn, *w_down, *g_post_ffn;
    float* out; unsigned char* ws;
};
__device__ __forceinline__ const float* x_row(const Params& p, int R) {
    if (R < 0) return nullptr;
    if (R < ROWS_P) { const int b = R / NPT, t = R - b * NPT; return t < 16 ? p.meta + (size_t)t * DM : p.xp + ((size_t)b * 4096 + (t - 16)) * DM; }
    if (R < ROWS_V) return p.xs + (size_t)(R - ROWS_P) * DM;
    return nullptr;
}

__device__ __forceinline__ int mu_row(int R) {
    if (R < ROWS_P) { const int b = R / NPT, t = R - b * NPT; return t >= 16 ? b * 4096 + (t - 16) : 16512 + b * 16 + t; }
    return 16384 + (R - ROWS_P);
}

namespace pg8 {
constexpr int BM = 256, BK = 64, HALF = 128, HTB = HALF * BK * 2, STAGE_BYTES = 8 * HTB, NXCD = 8, WGM = 8;
__host__ __device__ __forceinline__ int lds_byte(int r, int c) { const int st = (r >> 4) * 2 + (c >> 5), rr = r & 15, cc = c & 31, ob = rr * 64 + cc * 2; return st * 1024 + (ob ^ (((ob >> 9) & 1) << 5)); }
__host__ __device__ __forceinline__ void stage_rc(int b, int& R, int& C) { const int st = b / 1024, sb = b % 1024, swz = sb ^ (((sb >> 9) & 1) << 5); R = (st >> 1) * 16 + swz / 64; C = (st & 1) * 32 + (swz % 64) / 2; }
__host__ __device__ __forceinline__ int permB(int rho) { const int n = rho >> 4, i = rho & 15; return 8 * (i >> 2) + 4 * n + (i & 3); }
struct Unit { int pm, pn; };
struct Gemm { const bf16_t* A; const bf16_t* Bt; int K; size_t a_tstep; };
struct StaticOrder {
    int nM, nN, nwg, G, c;
    __device__ void init(int nM_, int nN_, int G_, int c_) { nM = nM_; nN = nN_; nwg = nM * nN; G = G_; c = c_; }
    __device__ bool next(int i, Unit& u) const {
        const long L = (long)i * G + c; if (L >= nwg) return false;
        int wgid = (int)L; { const int q = nwg / NXCD, r = nwg % NXCD, xcd = wgid % NXCD, off = wgid / NXCD; wgid = (xcd < r ? xcd * (q + 1) : r * (q + 1) + (xcd - r) * q) + off; }
        const int nig = WGM * nN, gid = wgid / nig, fm = gid * WGM, gsz = (nM - fm) < WGM ? (nM - fm) : WGM;
        u.pm = fm + ((wgid % nig) % gsz); u.pn = (wgid % nig) / gsz; return true;
    }
};
struct PanelOrder {
    int c;
    __device__ bool next(int i, Unit& u) const { if (i >= 2) return false; const int x = c & 7, j = c >> 3; u.pm = 32 * i + 4 * x + (j >> 3); u.pn = j & 7; return true; }
};
template <class Epi, class Sched = StaticOrder>
__device__ __forceinline__ void gemm_phase(LAS unsigned char* lds, const Gemm g, const Sched& S, const Epi& E) {
    int tid_ = threadIdx.x; asm volatile("" : "+v"(tid_));
    const int tid = tid_, wid = __builtin_amdgcn_readfirstlane(tid >> 6), lane = tid & 63, wr = wid >> 2, wc = wid & 3, fr = lane & 15, fq = lane >> 4;
    const int K = g.K, nt = K / BK;
    unsigned voffA[2], voffB[2];
#pragma unroll
    for (int i = 0; i < 2; ++i) { int R, C; stage_rc(tid * 16 + i * 8192, R, C); const int Rb = Epi::PERM ? ((R & ~31) + permB(R & 31)) : R;
        voffA[i] = (unsigned)(R * K + C) * 2u; voffB[i] = (unsigned)(Rb * K + C) * 2u; }
    const size_t kstep = (size_t)(BK * 2);
    const size_t hstep = (size_t)HALF * K * 2;
    const size_t tstepB = 2 * hstep, tstepA = g.a_tstep;
    const unsigned ldsw = (unsigned)wid * 1024u;
    const int aoff = lds_byte(wr * 64 + fr, fq * 8), boff = lds_byte(wc * 32 + fr, fq * 8);
#define PG8_SA(b, h) (((b) * 2 + (h)) * HTB)
#define PG8_SB(b, h) ((4 + (b) * 2 + (h)) * HTB)
#define PG8_STAGE(bufoff, gbase, voff) do { _Pragma("unroll") for (int _i = 0; _i < 2; ++_i) \
        __builtin_amdgcn_global_load_lds((const unsigned*)((const char*)(gbase) + (voff)[_i]), (LAS unsigned*)(lds + (bufoff) + ldsw + _i * 8192), 16, 0, 0); } while (0)
#define PG8_LDA(dst, b, h) do { _Pragma("unroll") for (int m = 0; m < 4; ++m) _Pragma("unroll") for (int k = 0; k < 2; ++k) dst[m][k] = *(const LAS bf16x8*)(lds + PG8_SA(b, h) + aoff + m * 2048 + k * 1024); } while (0)
#define PG8_LDB(dst, b, h) do { _Pragma("unroll") for (int n = 0; n < 2; ++n) _Pragma("unroll") for (int k = 0; k < 2; ++k) dst[n][k] = *(const LAS bf16x8*)(lds + PG8_SB(b, h) + boff + n * 2048 + k * 1024); } while (0)
#define PG8_MMA(ai, bj, At, Bt) do { __builtin_amdgcn_s_setprio(1); _Pragma("unroll") for (int m = 0; m < 4; ++m) _Pragma("unroll") for (int n = 0; n < 2; ++n) _Pragma("unroll") for (int k = 0; k < 2; ++k) \
        acc[ai][bj][m][n] = __builtin_amdgcn_mfma_f32_16x16x32_bf16(Bt[n][k], At[m][k], acc[ai][bj][m][n], 0, 0, 0); __builtin_amdgcn_s_setprio(0); } while (0)
#define PG8_WAIT_V(n) asm volatile("s_waitcnt vmcnt(" #n ")" ::: "memory")
#define PG8_WAIT_L(n) asm volatile("s_waitcnt lgkmcnt(" #n ")" ::: "memory")
#define PG8_BAR __builtin_amdgcn_s_barrier()
#define PG8_SCHED __builtin_amdgcn_sched_barrier(0)
    Unit cur, nxt; int ui = 0;
    if (!S.next(0, cur)) return;
    f32x4 acc[2][2][4][2];
#pragma unroll
    for (int a = 0; a < 2; ++a)
#pragma unroll
        for (int b = 0; b < 2; ++b)
#pragma unroll
            for (int m = 0; m < 4; ++m)
#pragma unroll
                for (int n = 0; n < 2; ++n) acc[a][b][m][n] = (f32x4){0.f, 0.f, 0.f, 0.f};
    bf16x8 At[4][2], B0[2][2], B1[2][2];
    const char* cA = (const char*)g.A + (size_t)cur.pm * tstepA; const char* cB = (const char*)g.Bt + (size_t)cur.pn * tstepB;
    PG8_STAGE(PG8_SB(0, 0), cB, voffB); PG8_STAGE(PG8_SB(0, 1), cB + hstep, voffB); PG8_STAGE(PG8_SA(0, 0), cA, voffA); PG8_STAGE(PG8_SA(0, 1), cA + hstep, voffA);
    if (wr == 1) PG8_BAR;
    PG8_WAIT_V(2); PG8_BAR;
    PG8_STAGE(PG8_SB(1, 0), cB + kstep, voffB); PG8_STAGE(PG8_SA(1, 0), cA + kstep, voffA); PG8_STAGE(PG8_SB(1, 1), cB + hstep + kstep, voffB);
    PG8_WAIT_V(6); PG8_BAR;
    for (;;) {
        const bool has_next = S.next(ui + 1, nxt);
        const char* nA = has_next ? (const char*)g.A + (size_t)nxt.pm * tstepA : cA; const char* nB = has_next ? (const char*)g.Bt + (size_t)nxt.pn * tstepB : cB;
        for (int t = 0; t < nt; t += 2) {
            const bool last = (t == nt - 2);
            const char* a1 = cA + (size_t)(t + 1) * kstep;
            const char* a2 = last ? nA : cA + (size_t)(t + 2) * kstep; const char* b2 = last ? nB : cB + (size_t)(t + 2) * kstep;
            const char* a3 = a2 + kstep; const char* b3 = b2 + kstep;
            PG8_LDB(B0, 0, 0); PG8_LDB(B1, 0, 1); PG8_SCHED; PG8_LDA(At, 0, 0); PG8_STAGE(PG8_SA(1, 1), a1 + hstep, voffA);
            PG8_WAIT_V(8); PG8_WAIT_L(0); PG8_BAR; PG8_MMA(0, 0, At, B0); PG8_MMA(0, 1, At, B1); PG8_BAR; PG8_SCHED;
            PG8_LDA(At, 0, 1); PG8_STAGE(PG8_SB(0, 0), b2, voffB); PG8_STAGE(PG8_SB(0, 1), b2 + hstep, voffB); PG8_STAGE(PG8_SA(0, 0), a2, voffA);
            PG8_WAIT_V(8); PG8_WAIT_L(0); PG8_BAR; PG8_MMA(1, 0, At, B0); PG8_MMA(1, 1, At, B1); PG8_BAR; PG8_SCHED;
            PG8_LDB(B0, 1, 0); PG8_LDB(B1, 1, 1); PG8_SCHED; PG8_LDA(At, 1, 0); PG8_STAGE(PG8_SA(0, 1), a2 + hstep, voffA);
            PG8_WAIT_V(8); PG8_WAIT_L(0); PG8_BAR; PG8_MMA(0, 0, At, B0); PG8_MMA(0, 1, At, B1); PG8_BAR; PG8_SCHED;
            PG8_LDA(At, 1, 1); PG8_STAGE(PG8_SB(1, 0), b3, voffB); PG8_STAGE(PG8_SB(1, 1), b3 + hstep, voffB); PG8_STAGE(PG8_SA(1, 0), a3, voffA);
            PG8_WAIT_V(8); PG8_WAIT_L(0); PG8_BAR; PG8_MMA(1, 0, At, B0); PG8_MMA(1, 1, At, B1); PG8_BAR; PG8_SCHED;
        }
        if (wr == 0) PG8_BAR;
        E(acc, cur, wr, wc, fr, fq);
        if (!has_next) break;
#pragma unroll
        for (int a = 0; a < 2; ++a)
#pragma unroll
            for (int b = 0; b < 2; ++b)
#pragma unroll
                for (int m = 0; m < 4; ++m)
#pragma unroll
                    for (int n = 0; n < 2; ++n) acc[a][b][m][n] = (f32x4){0.f, 0.f, 0.f, 0.f};
        cur = nxt; cA = nA; cB = nB; ++ui;
        if (wr == 1) PG8_BAR;
    }
    PG8_WAIT_V(0);
    PG8_BAR;
#undef PG8_SA
#undef PG8_SB
#undef PG8_STAGE
#undef PG8_LDA
#undef PG8_LDB
#undef PG8_MMA
#undef PG8_WAIT_V
#undef PG8_WAIT_L
#undef PG8_BAR
#undef PG8_SCHED
}

struct EpiProj {
    static constexpr bool PERM = true;
    bf16_t* proj; bf16_t* z; float* ab;
    __device__ __forceinline__ void operator()(const f32x4 (&acc)[2][2][4][2], const Unit& u, int wr, int wc, int fr, int fq) const {
        const int row0 = u.pm * BM + wr * 64 + fr;
        if (u.pn < 28) {
            bf16_t* base; int ldc;
            if (u.pn < 24) { base = proj + u.pn * 256 + wc * 32 + 8 * fq; ldc = 6144; } else { base = z + (u.pn - 24) * 256 + wc * 32 + 8 * fq; ldc = 1024; }
#pragma unroll
            for (int ai = 0; ai < 2; ++ai)
#pragma unroll
                for (int m = 0; m < 4; ++m) { bf16_t* rowp = base + (size_t)(row0 + ai * HALF + m * 16) * ldc;
#pragma unroll
                    for (int bj = 0; bj < 2; ++bj) { const f32x4 v0 = acc[ai][bj][m][0], v1 = acc[ai][bj][m][1];
                        u32x4 w; w.x = cvt_pk_bf16(v0[0], v0[1]); w.y = cvt_pk_bf16(v0[2], v0[3]); w.z = cvt_pk_bf16(v1[0], v1[1]); w.w = cvt_pk_bf16(v1[2], v1[3]);
                        *(u32x4*)(rowp + bj * HALF) = w; } }
        } else if (wc == 0 && fq < 2) {
#pragma unroll
            for (int ai = 0; ai < 2; ++ai)
#pragma unroll
                for (int m = 0; m < 4; ++m) { float* rowp = ab + (size_t)(row0 + ai * HALF + m * 16) * 16 + 8 * fq;
                    *(f32x4*)(rowp) = acc[ai][0][m][0]; *(f32x4*)(rowp + 4) = acc[ai][0][m][1]; }
        }
    }
};
struct EpiBf16Part {
    static constexpr bool PERM = false;
    bf16_t* outb; float* part;
    __device__ __forceinline__ void operator()(const f32x4 (&acc)[2][2][4][2], const Unit& u, int wr, int wc, int fr, int fq) const {
#pragma unroll
        for (int ai = 0; ai < 2; ++ai)
#pragma unroll
            for (int m = 0; m < 4; ++m) {
                const int r = u.pm * BM + ai * HALF + wr * 64 + m * 16 + fr;
                bf16_t* rowp = outb + (size_t)r * DM + u.pn * BM + wc * 32 + 4 * fq;
                float ss = 0.f;
#pragma unroll
                for (int bj = 0; bj < 2; ++bj)
#pragma unroll
                    for (int n = 0; n < 2; ++n) { const f32x4 v = acc[ai][bj][m][n]; ss += (v[0] * v[0] + v[1] * v[1]) + (v[2] * v[2] + v[3] * v[3]);
                        u32x2 w; w.x = cvt_pk_bf16(v[0], v[1]); w.y = cvt_pk_bf16(v[2], v[3]); *(u32x2*)(rowp + bj * HALF + n * 16) = w; }
                ss += __shfl_xor(ss, 16); ss += __shfl_xor(ss, 32);
                if (fq == 0) part[(size_t)r * 32 + u.pn * 4 + wc] = ss;
            }
    }
};
struct EpiFinal {
    static constexpr bool PERM = false;
    float* yout; const bf16_t* x1; const float* g; float* xbuf; unsigned* cnt; LAS float* ex;
    __device__ __forceinline__ void operator()(const f32x4 (&acc)[2][2][4][2], const Unit& u, int wr, int wc, int fr, int fq) const {
        const int tid = threadIdx.x;
        LAS float* P = ex; LAS float* RN = ex + 1024; LAS unsigned* flag = (LAS unsigned*)(ex + 1280);
#pragma unroll
        for (int ai = 0; ai < 2; ++ai)
#pragma unroll
            for (int m = 0; m < 4; ++m) { float ss = 0.f;
#pragma unroll
                for (int bj = 0; bj < 2; ++bj)
#pragma unroll
                    for (int n = 0; n < 2; ++n) { const f32x4 v = acc[ai][bj][m][n]; ss += (v[0] * v[0] + v[1] * v[1]) + (v[2] * v[2] + v[3] * v[3]); }
                ss += __shfl_xor(ss, 16); ss += __shfl_xor(ss, 32);
                if (fq == 0) P[(ai * HALF + wr * 64 + m * 16 + fr) * 4 + wc] = ss; }
        asm volatile("s_waitcnt lgkmcnt(0)" ::: "memory"); __builtin_amdgcn_s_barrier(); asm volatile("" ::: "memory");
        if (tid < 256) { const f32x4 pv = *(const LAS f32x4*)(P + tid * 4);
            __hip_atomic_store(xbuf + (size_t)(u.pm * 8 + u.pn) * 256 + tid, (pv[0] + pv[1]) + (pv[2] + pv[3]), __ATOMIC_RELAXED, __HIP_MEMORY_SCOPE_AGENT); }
        asm volatile("s_waitcnt vmcnt(0)" ::: "memory"); __builtin_amdgcn_s_barrier(); asm volatile("" ::: "memory");
        if (tid == 0) {
            __builtin_amdgcn_fence(__ATOMIC_RELEASE, "agent");
            __hip_atomic_fetch_add(cnt + 64 * u.pm, 1u, __ATOMIC_RELAXED, __HIP_MEMORY_SCOPE_AGENT);
            unsigned sp = 0u; while (__hip_atomic_load(cnt + 64 * u.pm, __ATOMIC_RELAXED, __HIP_MEMORY_SCOPE_AGENT) < 8u && sp < (1u << 24)) { __builtin_amdgcn_s_sleep(1); ++sp; }
            __builtin_amdgcn_fence(__ATOMIC_ACQUIRE, "agent");
            flag[0] = 1u;
        }
        asm volatile("s_waitcnt vmcnt(0) lgkmcnt(0)" ::: "memory"); __builtin_amdgcn_s_barrier(); asm volatile("" ::: "memory");
        if (tid < 256) { float tot = 0.f;
#pragma unroll
            for (int t8 = 0; t8 < 8; ++t8) tot += __hip_atomic_load(xbuf + (size_t)(u.pm * 8 + t8) * 256 + tid, __ATOMIC_RELAXED, __HIP_MEMORY_SCOPE_AGENT);
            RN[tid] = rsqrtf(tot * (1.f / DM) + EPS); }
        asm volatile("s_waitcnt vmcnt(0) lgkmcnt(0)" ::: "memory"); __builtin_amdgcn_s_barrier(); asm volatile("" ::: "memory");
        const int col0 = u.pn * BM + wc * 32 + 4 * fq;
#pragma unroll
        for (int ai = 0; ai < 2; ++ai)
#pragma unroll
            for (int m = 0; m < 4; ++m) {
                const int rl = ai * HALF + wr * 64 + m * 16 + fr, q = u.pm * BM + rl; const float rn = RN[rl];
                const int R = (q >> 12) * NPT + 16 + (q & 4095);
                const bf16_t* xp = x1 + (size_t)R * DM + col0; float* yp = yout + (size_t)q * DM + col0;
#pragma unroll
                for (int bj = 0; bj < 2; ++bj)
#pragma unroll
                    for (int n = 0; n < 2; ++n) { const int co = bj * HALF + n * 16; const u32x2 xr2 = *(const u32x2*)(xp + co); const f32x4 gg = *(const f32x4*)(g + col0 + co);
                        const f32x4 xv = (f32x4){bflo(xr2.x), bfhi(xr2.x), bflo(xr2.y), bfhi(xr2.y)};
                        *(f32x4*)(yp + co) = xv + acc[ai][bj][m][n] * rn * gg; }
            }
    }
};
struct EpiGate {
    static constexpr bool PERM = true;
    bf16_t* F; const float* wcf; const float* st_ffn; float* outb; LAS float* exch;
    __device__ __forceinline__ void operator()(const f32x4 (&acc)[2][2][4][2], const Unit& u, int wr, int wc, int fr, int fq) const {
        const int lane = fr + 16 * fq;
        if (fr >= 14) {
#pragma unroll
            for (int ai = 0; ai < 2; ++ai)
#pragma unroll
                for (int n = 0; n < 2; ++n) *(LAS f32x4*)(exch + (((((ai * 2 + wr) * 4 + wc) * 2 + (fr - 14)) * 2 + n) * 16) + fq * 4) = acc[ai][0][3][n];
        }
        asm volatile("s_waitcnt lgkmcnt(0)" ::: "memory"); __builtin_amdgcn_s_barrier(); asm volatile("" ::: "memory");
        const int j0 = u.pn * 128 + wc * 32 + 8 * fq;
        f32x4 w0[2], w1[2], w2[2];
#pragma unroll
        for (int n = 0; n < 2; ++n) { w0[n] = *(const f32x4*)(wcf + j0 + 4 * n); w1[n] = *(const f32x4*)(wcf + DFF + j0 + 4 * n); w2[n] = *(const f32x4*)(wcf + 2 * DFF + j0 + 4 * n); }
        const int src1 = (lane & 48) | ((fr - 1) & 15), src2 = (lane & 48) | ((fr - 2) & 15);
#pragma unroll
        for (int ai = 0; ai < 2; ++ai) {
            const int sl = 2 * ai + wr;
            f32x4 gprev[2];
#pragma unroll
            for (int n = 0; n < 2; ++n) { gprev[n] = (f32x4){0.f, 0.f, 0.f, 0.f};
                if (sl > 0 && fr >= 14) gprev[n] = *(const LAS f32x4*)(exch + ((((sl - 1) * 4 + wc) * 2 + (fr - 14)) * 2 + n) * 16 + fq * 4); }
#pragma unroll
            for (int m = 0; m < 4; ++m) {
                const int lr = ai * HALF + wr * 64 + m * 16 + fr, R = u.pm * 254 - 2 + lr;
                int t, Tseq, sq; bool samp = false;
                if (R < ROWS_P) { sq = R / NPT; t = R - sq * NPT; Tseq = NPT; if (R < 0) { sq = 0; t = 100; } }
                else { samp = true; sq = (R - ROWS_P) >> 4; t = (R - ROWS_P) & 15; Tseq = 16; }
                const bool valid = (lr >= 2) && (R < ROWS_V);
                u32x4 pk;
#pragma unroll
                for (int n = 0; n < 2; ++n) {
                    const f32x4 cur = acc[ai][0][m][n]; const f32x4 pm = (m == 0) ? gprev[n] : acc[ai][0][m == 0 ? 0 : m - 1][n];
                    f32x4 p1, p2;
#pragma unroll
                    for (int i = 0; i < 4; ++i) { const float r1 = (fr == 15) ? pm[i] : cur[i], r2 = (fr >= 14) ? pm[i] : cur[i]; p1[i] = __shfl(r1, src1); p2[i] = __shfl(r2, src2); }
                    if (valid && t < 2) {
                        f32x4 h0 = (f32x4){0.f, 0.f, 0.f, 0.f}, h1 = h0;
                        if (samp) { h0 = *(const f32x4*)(st_ffn + ((size_t)sq * 2 + 0) * DFF + j0 + 4 * n); h1 = *(const f32x4*)(st_ffn + ((size_t)sq * 2 + 1) * DFF + j0 + 4 * n); }
                        if (t == 0) { p1 = h1; p2 = h0; } else { p2 = h1; }
                    }
                    const f32x4 gc = w0[n] * p2 + w1[n] * p1 + w2[n] * cur; const f32x4 vv = acc[ai][1][m][n];
                    const float f0 = silu_f(gc[0]) * vv[0], f1 = silu_f(gc[1]) * vv[1], f2 = silu_f(gc[2]) * vv[2], f3 = silu_f(gc[3]) * vv[3];
                    if (n == 0) { pk.x = cvt_pk_bf16(f0, f1); pk.y = cvt_pk_bf16(f2, f3); } else { pk.z = cvt_pk_bf16(f0, f1); pk.w = cvt_pk_bf16(f2, f3); }
                    if (valid && t >= Tseq - 2) { float* d = outb + (samp ? O_NFC_S : O_NFC_P) + ((size_t)sq * 2 + (t - (Tseq - 2))) * DFF + j0 + 4 * n; *(f32x4*)d = cur; }
                }
                if (valid && (samp || t >= 16)) { const int frow = samp ? 16384 + (R - ROWS_P) : sq * 4096 + (t - 16); *(u32x4*)(F + (size_t)frow * DFF + j0) = pk; }
            }
        }
    }
};
}

__device__ __forceinline__ void transpose_item(const float* W, int ldw, int k0, int n0, bf16_t* WT, int K, int drow0, LAS float* scr, int lane) {
#pragma unroll 8
    for (int i = 0; i < 32; ++i) { const int kk = 2 * i + (lane >> 5); scr[kk * 33 + (lane & 31)] = __builtin_nontemporal_load(W + (size_t)(k0 + kk) * ldw + n0 + (lane & 31)); }
    LDS_WAIT();
    const int c = lane & 7;
#pragma unroll
    for (int j = 0; j < 4; ++j) { const int n = (lane >> 3) + 8 * j; const LAS float* s = scr + (8 * c) * 33 + n;
        u32x4 o; o.x = cvt_pk_bf16(s[0 * 33], s[1 * 33]); o.y = cvt_pk_bf16(s[2 * 33], s[3 * 33]); o.z = cvt_pk_bf16(s[4 * 33], s[5 * 33]); o.w = cvt_pk_bf16(s[6 * 33], s[7 * 33]);
        *(u32x4*)(WT + (size_t)(drow0 + n) * K + k0 + 8 * c) = o; }
    LDS_WAIT();
}
__device__ __forceinline__ void transpose_issue(float (&r)[32], const float* W, int ldw, int k0, int n0, int lane) {
#pragma unroll
    for (int i = 0; i < 32; ++i) { const int kk = 2 * i + (lane >> 5); r[i] = __builtin_nontemporal_load(W + (size_t)(k0 + kk) * ldw + n0 + (lane & 31)); }
}
__device__ __forceinline__ void transpose_finish(const float (&r)[32], bf16_t* WT, int K, int k0, int drow0, LAS float* scr, int lane) {
#pragma unroll
    for (int i = 0; i < 32; ++i) { const int kk = 2 * i + (lane >> 5); scr[kk * 33 + (lane & 31)] = r[i]; }
    LDS_WAIT();
    const int c = lane & 7;
#pragma unroll
    for (int j = 0; j < 4; ++j) { const int n = (lane >> 3) + 8 * j; const LAS float* s = scr + (8 * c) * 33 + n;
        u32x4 o; o.x = cvt_pk_bf16(s[0 * 33], s[1 * 33]); o.y = cvt_pk_bf16(s[2 * 33], s[3 * 33]); o.z = cvt_pk_bf16(s[4 * 33], s[5 * 33]); o.w = cvt_pk_bf16(s[6 * 33], s[7 * 33]);
        *(u32x4*)(WT + (size_t)(drow0 + n) * K + k0 + 8 * c) = o; }
    LDS_WAIT();
}
__device__ __forceinline__ void norm_store_bf16(const f32x4 (&v)[8], const float* g, bf16_t* orow, int lane) {
    float s = 0.f;
#pragma unroll
    for (int j = 0; j < 8; ++j) s += (v[j][0] * v[j][0] + v[j][1] * v[j][1]) + (v[j][2] * v[j][2] + v[j][3] * v[j][3]);
    const float r = rsqrtf(wave_sum(s) * (1.f / DM) + EPS);
#pragma unroll
    for (int j = 0; j < 8; ++j) { const f32x4 gg = *(const f32x4*)(g + 4 * lane + 256 * j); const f32x4 o = v[j] * r * gg;
        u32x2 w; w.x = cvt_pk_bf16(o[0], o[1]); w.y = cvt_pk_bf16(o[2], o[3]); *(u32x2*)(orow + 4 * lane + 256 * j) = w; }
}

template <int I> __device__ __forceinline__ void subst_row(float (&x)[64], const LAS float* Mm, float r) {
#pragma unroll
    for (int j4 = 0; j4 < I; j4 += 4) { const f32x4 mv = *(const LAS f32x4*)(Mm + I * 64 + j4);
#pragma unroll
        for (int e = 0; e < 4; ++e) if (j4 + e < I) r -= mv[e] * x[j4 + e]; }
    x[I] = r;
    __builtin_amdgcn_sched_barrier(0);
}
template <int I> struct SubstAll {
    static __device__ __forceinline__ void run(float (&x)[64], const LAS float* Mm, const LAS bf16_t* srcc, const LAS float* scl) {
        SubstAll<I - 1>::run(x, Mm, srcc, scl);
        subst_row<I>(x, Mm, bf2f(srcc[I * 136]) * scl[I]);
    }
};
template <> struct SubstAll<-1> { static __device__ __forceinline__ void run(float (&)[64], const LAS float*, const LAS bf16_t*, const LAS float*) {} };

#define GDN_STEP_BODY(LD8, LD4) \
    bf16x8 Sb[4]; \
    _Pragma("unroll") for (int kb = 0; kb < 4; ++kb) { u32x4 w; w.x = cvt_pk_bf16(S[2 * kb][0], S[2 * kb][1]); w.y = cvt_pk_bf16(S[2 * kb][2], S[2 * kb][3]); w.z = cvt_pk_bf16(S[2 * kb + 1][0], S[2 * kb + 1][1]); w.w = cvt_pk_bf16(S[2 * kb + 1][2], S[2 * kb + 1][3]); \
        Sb[kb] = __builtin_bit_cast(bf16x8, w); } \
    bf16x8 fa[16]; u32x2 ur[4]; \
    _Pragma("unroll") for (int tt = 0; tt < 4; ++tt) { _Pragma("unroll") for (int kb = 0; kb < 4; ++kb) fa[4 * tt + kb] = LD8(Wg + (16 * tt + fr) * 128 + 32 * kb + 8 * fq); ur[tt] = LD4(Us + fr * 64 + 16 * tt + 4 * fq); } \
    f32x4 vn[4]; \
    { f32x4 P[4]; \
      _Pragma("unroll") for (int tt = 0; tt < 4; ++tt) P[tt] = (f32x4){0.f, 0.f, 0.f, 0.f}; \
      _Pragma("unroll") for (int kb = 0; kb < 4; ++kb) _Pragma("unroll") for (int tt = 0; tt < 4; ++tt) P[tt] = __builtin_amdgcn_mfma_f32_16x16x32_bf16(fa[4 * tt + kb], Sb[kb], P[tt], 0, 0, 0); \
      _Pragma("unroll") for (int tt = 0; tt < 4; ++tt) { vn[tt][0] = bflo(ur[tt].x) - P[tt][0]; vn[tt][1] = bfhi(ur[tt].x) - P[tt][1]; vn[tt][2] = bflo(ur[tt].y) - P[tt][2]; vn[tt][3] = bfhi(ur[tt].y) - P[tt][3]; } } \
    _Pragma("unroll") for (int tt = 0; tt < 4; ++tt) _Pragma("unroll") for (int kb = 0; kb < 4; ++kb) fa[4 * tt + kb] = LD8(Wg + 8192 + (16 * tt + fr) * 128 + 32 * kb + 8 * fq); \
    bf16x8 fb[6]; \
    fb[0] = LD8(Wg + 24576 + (fr) * 64 + 8 * fq); fb[1] = LD8(Wg + 24576 + (16 + fr) * 64 + 8 * fq); \
    fb[2] = LD8(Wg + 24576 + (32 + fr) * 64 + 8 * fq); fb[3] = LD8(Wg + 24576 + (32 + fr) * 64 + 32 + 8 * fq); \
    fb[4] = LD8(Wg + 24576 + (48 + fr) * 64 + 8 * fq); fb[5] = LD8(Wg + 24576 + (48 + fr) * 64 + 32 + 8 * fq); \
    bf16x8 Vb2[2]; \
    _Pragma("unroll") for (int k2 = 0; k2 < 2; ++k2) { u32x4 w; w.x = cvt_pk_bf16(vn[2 * k2][0], vn[2 * k2][1]); w.y = cvt_pk_bf16(vn[2 * k2][2], vn[2 * k2][3]); w.z = cvt_pk_bf16(vn[2 * k2 + 1][0], vn[2 * k2 + 1][1]); w.w = cvt_pk_bf16(vn[2 * k2 + 1][2], vn[2 * k2 + 1][3]); \
        Vb2[k2] = __builtin_bit_cast(bf16x8, w); } \
    f32x4 O[4]; \
    _Pragma("unroll") for (int tt = 0; tt < 4; ++tt) O[tt] = (f32x4){0.f, 0.f, 0.f, 0.f}; \
    _Pragma("unroll") for (int kb = 0; kb < 4; ++kb) _Pragma("unroll") for (int tt = 0; tt < 4; ++tt) O[tt] = __builtin_amdgcn_mfma_f32_16x16x32_bf16(fa[4 * tt + kb], Sb[kb], O[tt], 0, 0, 0); \
    O[0] = __builtin_amdgcn_mfma_f32_16x16x32_bf16(fb[0], Vb2[0], O[0], 0, 0, 0); O[1] = __builtin_amdgcn_mfma_f32_16x16x32_bf16(fb[1], Vb2[0], O[1], 0, 0, 0); \
    O[2] = __builtin_amdgcn_mfma_f32_16x16x32_bf16(fb[2], Vb2[0], O[2], 0, 0, 0); O[2] = __builtin_amdgcn_mfma_f32_16x16x32_bf16(fb[3], Vb2[1], O[2], 0, 0, 0); \
    O[3] = __builtin_amdgcn_mfma_f32_16x16x32_bf16(fb[4], Vb2[0], O[3], 0, 0, 0); O[3] = __builtin_amdgcn_mfma_f32_16x16x32_bf16(fb[5], Vb2[1], O[3], 0, 0, 0); \
    _Pragma("unroll") for (int dt = 0; dt < 8; ++dt) _Pragma("unroll") for (int k2 = 0; k2 < 2; ++k2) fa[2 * dt + k2] = LD8(Wg + 16384 + (16 * dt + fr) * 64 + 32 * k2 + 8 * fq); \
    if (tok0 >= 0 && tok0 + 64 <= Tseq) { \
        _Pragma("unroll") for (int tt = 0; tt < 4; ++tt) _Pragma("unroll") for (int jj = 0; jj < 4; ++jj) obase[(size_t)(tok0 + 16 * tt + 4 * fq + jj) * 1024] = O[tt][jj]; \
    } else { \
        _Pragma("unroll") for (int tt = 0; tt < 4; ++tt) _Pragma("unroll") for (int jj = 0; jj < 4; ++jj) { const int tk = tok0 + 16 * tt + 4 * fq + jj; if (tk >= 0 && tk < Tseq) obase[(size_t)tk * 1024] = O[tt][jj]; } \
    } \
    _Pragma("unroll") for (int dt = 0; dt < 8; ++dt) S[dt] = S[dt] * egl; \
    _Pragma("unroll") for (int k2 = 0; k2 < 2; ++k2) _Pragma("unroll") for (int dt = 0; dt < 8; ++dt) S[dt] = __builtin_amdgcn_mfma_f32_16x16x32_bf16(fa[2 * dt + k2], Vb2[k2], S[dt], 0, 0, 0);
__device__ __forceinline__ void gdn_step_lds(f32x4 (&S)[8], const LAS bf16_t* Wg, const LAS bf16_t* Us, float egl, float* obase, int tok0, int Tseq, int fr, int fq) {
#define LD8L(p) (*(const LAS bf16x8*)(p))
#define LD4L(p) (*(const LAS u32x2*)(p))
    GDN_STEP_BODY(LD8L, LD4L)
}
__device__ __forceinline__ void gdn_step_glb(f32x4 (&S)[8], const bf16_t* Wg, const bf16_t* Us, float egl, float* obase, int tok0, int Tseq, int fr, int fq) {
#define LD8G(p) (*(const bf16x8*)(p))
#define LD4G(p) (*(const u32x2*)(p))
    GDN_STEP_BODY(LD8G, LD4G)
}

#define XB_TMO      128
#define XB_XCNT(j)  (256  + 64 * (j))
#define XB_XSUB(j)  (1280 + 64 * (j))
#define XB_XGEN(j)  (2304 + 64 * (j))
#define XB_TOP      3328
#define XB_TOPGEN   3392
#define XCD_BAR_WORDS 3456
#define XB_SPIN_CAP (1u << 22)
__device__ __forceinline__ unsigned xb_ld(unsigned* p)              { return __hip_atomic_load(p, __ATOMIC_RELAXED, __HIP_MEMORY_SCOPE_AGENT); }
__device__ __forceinline__ unsigned xb_add(unsigned* p, unsigned v) { return __hip_atomic_fetch_add(p, v, __ATOMIC_RELAXED, __HIP_MEMORY_SCOPE_AGENT); }
__device__ __forceinline__ unsigned xb_xcc_id() { return (unsigned)__builtin_amdgcn_s_getreg((3 << 11) | 20) & 0xFu; }
#define XB_SPIN(cond, bar) do { unsigned _sp = 0; while (cond) { __builtin_amdgcn_s_sleep(1); \
    if ((++_sp & 255u) == 0u) { if (xb_ld(&(bar)[XB_TMO])) break; if (_sp > XB_SPIN_CAP) { atomicAdd(&(bar)[XB_TMO], 1u); break; } } } } while (0)
struct XcdBarrier { unsigned* bar; unsigned x; volatile LAS unsigned* st; };
__device__ __forceinline__ XcdBarrier xcd_barrier_post(unsigned* bar, volatile LAS unsigned* st) {
    XcdBarrier b; b.bar = bar; b.x = xb_xcc_id(); b.st = st;
    if (threadIdx.x == 0) (void)xb_add(&bar[XB_XCNT(b.x)], 1u);
    return b;
}
__device__ __forceinline__ void xcd_barrier_complete(unsigned* bar, unsigned x, unsigned& nloc, unsigned& nx) {
    const unsigned G = gridDim.x * gridDim.y * gridDim.z;
    unsigned sum, cnt, mine, sp = 0u;
    for (;;) {
        sum = 0u; cnt = 0u; mine = 0u;
#pragma unroll
        for (unsigned j = 0; j < 16; ++j) { const unsigned c = xb_ld(&bar[XB_XCNT(j)]); sum += c; cnt += (c > 0u) ? 1u : 0u; mine = (j == x) ? c : mine; }
        if (sum == G) break;
        __builtin_amdgcn_s_sleep(1);
        if ((++sp & 255u) == 0u) { if (xb_ld(&bar[XB_TMO])) break; if (sp > XB_SPIN_CAP) { atomicAdd(&bar[XB_TMO], 1u); break; } }
    }
    nloc = mine > 0u ? mine : 1u; nx = cnt > 0u ? cnt : 1u;
}
__device__ __forceinline__ void xcd_barrier(const XcdBarrier& b) {
    asm volatile("s_waitcnt vmcnt(0)" ::: "memory");
    __syncthreads();
    if (threadIdx.x == 0) {
        unsigned* bar = b.bar;
        __builtin_amdgcn_s_waitcnt(0);
        unsigned nloc = b.st[0], nx = b.st[1];
        if (nloc == 0u) { xcd_barrier_complete(bar, b.x, nloc, nx); b.st[0] = nloc; b.st[1] = nx; }
        const unsigned old = xb_add(&bar[XB_XSUB(b.x)], 1u);
        const unsigned gen = old / nloc;
        if (old + 1u == (gen + 1u) * nloc) {
            __builtin_amdgcn_fence(__ATOMIC_RELEASE, "agent");
            asm volatile("s_waitcnt vmcnt(0)" ::: "memory");
            const unsigned og = xb_add(&bar[XB_TOP], 1u);
            const unsigned tg = og / nx;
            if (og + 1u == (tg + 1u) * nx) xb_add(&bar[XB_TOPGEN], 1u);
            else XB_SPIN(xb_ld(&bar[XB_TOPGEN]) == tg, bar);
            __builtin_amdgcn_fence(__ATOMIC_ACQUIRE, "agent");
            xb_add(&bar[XB_XGEN(b.x)], 1u);
            asm volatile("s_waitcnt vmcnt(0)" ::: "memory");
        } else {
            XB_SPIN(xb_ld(&bar[XB_XGEN(b.x)]) == gen, bar);
            __builtin_amdgcn_fence(__ATOMIC_ACQUIRE, "agent");
            asm volatile("s_waitcnt vmcnt(0)" ::: "memory");
        }
    }
    __syncthreads();
}

__global__ void __launch_bounds__(512, 2) hymba_fwd(Params p) {
    extern __shared__ __attribute__((aligned(16))) unsigned char lds_raw[];
    LAS unsigned char* lds = (LAS unsigned char*)lds_raw;
    const int G = gridDim.x, bx = blockIdx.x, NGW = G * 8, NGT = G * 512;
#define PHASE_LOCALS int tid = threadIdx.x; asm volatile("" : "+v"(tid)); const int lane = tid & 63, wave = __builtin_amdgcn_readfirstlane(tid >> 6), gw = bx * 8 + wave, gtid = bx * 512 + tid; (void)gw; (void)gtid; (void)lane;
    unsigned char* ws = p.ws;
    bf16_t* Wt_in = (bf16_t*)(ws + WS_WIN); bf16_t* Wt_down = (bf16_t*)(ws + WS_WDOWN); bf16_t* Wt_out = (bf16_t*)(ws + WS_WOUT); bf16_t* Wt_up = (bf16_t*)(ws + WS_WUP);
    bf16_t* Bm = (bf16_t*)(ws + WS_B) + 2 * DM;
    bf16_t* PROJ = (bf16_t*)(ws + WS_C); float* OBUF = (float*)(ws + WS_C); bf16_t* MOb = (bf16_t*)(ws + WS_C); bf16_t* FOb = (bf16_t*)(ws + WS_B); bf16_t* Fb = (bf16_t*)(ws + WS_F);
    bf16_t* Zb = (bf16_t*)(ws + WS_Z); float* AB = (float*)(ws + WS_AB); float* PART = (float*)(ws + WS_PART); float* EGL = (float*)(ws + WS_EGL);
    unsigned char* GDN = ws + WS_GDN; bf16_t* X1 = (bf16_t*)(ws + WS_X1);
    float* out = p.out;
    if (threadIdx.x < 2) ((volatile LAS unsigned*)(lds + LDS_BYTES - 64))[threadIdx.x] = 0u;
    __syncthreads();
    const XcdBarrier xbar = xcd_barrier_post((unsigned*)ws, (volatile LAS unsigned*)(lds + LDS_BYTES - 64));

    PH(0) {
        PHASE_LOCALS
        LAS float* scr = (LAS float*)(lds + wave * 8448);
        constexpr int I_IN = 32 * 224, I_OUT = 32 * 64;
        for (int it = gw; it < I_IN + I_OUT; it += NGW) {
            if (it < I_IN) { const int kb = it / 224, nb = it - kb * 224; transpose_item(p.w_in, INC, 64 * kb, 32 * nb, Wt_in, DM, 32 * nb, scr, lane); }
            else { const int r = it - I_IN, kb = r >> 6, nb = r & 63; transpose_item(p.w_out, DM, 64 * kb, 32 * nb, Wt_out, DM, 32 * nb, scr, lane); }
        }
        for (int idx = gtid; idx < 16 * DM; idx += NGT) { const int n = idx >> 11, k = idx & 2047; Wt_in[(size_t)(7168 + n) * DM + k] = f2bf(p.w_in[(size_t)k * INC + 7168 + n]); }
        for (int idx = gtid; idx < 240 * DM / 8; idx += NGT) ((u32x4*)(Wt_in + (size_t)7184 * DM))[idx] = (u32x4){0u, 0u, 0u, 0u};
        {
            f32x4 nx[8]; const float* xr = x_row(p, gw);
#pragma unroll
            for (int j = 0; j < 8; ++j) nx[j] = xr ? __builtin_nontemporal_load((const f32x4*)(xr + 4 * lane + 256 * j)) : (f32x4){0.f, 0.f, 0.f, 0.f};
#pragma unroll 1
            for (int R = gw; R < T_PAD; R += NGW) {
                f32x4 v[8]; const bool live = xr != nullptr;
#pragma unroll
                for (int j = 0; j < 8; ++j) v[j] = nx[j];
                xr = (R + NGW < T_PAD) ? x_row(p, R + NGW) : nullptr;
                if (xr) {
#pragma unroll
                    for (int j = 0; j < 8; ++j) nx[j] = __builtin_nontemporal_load((const f32x4*)(xr + 4 * lane + 256 * j));
                }
                bf16_t* orow = Bm + (size_t)R * DM;
                if (live) norm_store_bf16(v, p.g_pre_mix, orow, lane);
                else {
#pragma unroll
                    for (int j = 0; j < 8; ++j) *(u32x2*)(orow + 4 * lane + 256 * j) = (u32x2){0u, 0u};
                }
            }
        }
    }
    xcd_barrier(xbar);

    PH(1) {
        PHASE_LOCALS
        pg8::Gemm g{Bm, Wt_in, DM, (size_t)256 * DM * 2}; pg8::StaticOrder S; S.init(65, 29, G, bx);
        pg8::EpiProj E{PROJ, Zb, AB};
        pg8::gemm_phase<pg8::EpiProj>(lds, g, S, E);
    }
    xcd_barrier(xbar);

    PH(2) {
        PHASE_LOCALS
        const int half = tid >> 8, t = tid & 255, hw = wave & 3;
        LAS unsigned char* L = lds + half * 70656;
        LAS bf16_t* Kb = (LAS bf16_t*)L; LAS bf16_t* Qb = (LAS bf16_t*)(L + 17408); LAS bf16_t* Vb = (LAS bf16_t*)(L + 34816);
        LAS float* Mm = (LAS float*)(L + 52224); LAS float* gc = (LAS float*)(L + 68608); LAS float* bt = gc + 64; LAS float* eg = gc + 128; LAS float* bw = gc + 192; LAS float* kdv = gc + 256;
        const int fr = lane & 15, fq = lane >> 4;
        for (int pr = bx; pr < NITEM / 2; pr += G) {
            const int item = 2 * pr + half;
            int h, tok0, Tseq, rowbase, sidx; bool samp;
            if (item < NITEM_P) { const int bh = item / 65, c = item - bh * 65; sidx = bh >> 3; h = bh & 7; tok0 = 64 * c - 48; Tseq = NPT; rowbase = sidx * NPT; samp = false; }
            else { const int sh = item - NITEM_P; sidx = sh >> 3; h = sh & 7; tok0 = 0; Tseq = 16; rowbase = ROWS_P + 16 * sidx; samp = true; }
            unsigned char* blob = GDN + (size_t)item * BLOB;
            bf16_t* Wg = (bf16_t*)blob; bf16_t* QGg = Wg + 8192; bf16_t* KDTg = Wg + 16384; bf16_t* ATTg = Wg + 24576; bf16_t* UTg = Wg + 28672;
            if (t < 64) {
                const int tk = tok0 + t; float gval = 0.f, bval = 0.f;
                if (tk >= 0 && tk < Tseq) { const float* abr = AB + (size_t)(rowbase + tk) * 16; const float bl = abr[h], al = abr[8 + h] + p.dt_bias[h];
                    bval = 1.f / (1.f + __expf(-bl)); const float sp = al > 20.f ? al : log1pf(__expf(al)); gval = -__expf(p.a_log[h]) * sp; }
                float cs = gval;
#pragma unroll
                for (int o = 1; o < 64; o <<= 1) { const float y = __shfl_up(cs, o); if (lane >= o) cs += y; }
                gc[t] = cs; bt[t] = bval; eg[t] = __expf(cs); bw[t] = bval * __expf(cs); kdv[t] = __expf(__shfl(cs, 63) - cs);
            }
            { LAS float* wl = Mm;
#pragma unroll
              for (int i = 0; i < 6; ++i) { const int v = t + 256 * i, j = v / 384, r = v - j * 384; wl[v] = p.w_conv_gdn[(size_t)j * 3072 + (r >> 7) * 1024 + h * 128 + (r & 127)]; } }
            __syncthreads();
            P2(0)
#pragma unroll 1
            for (int ib = 0; ib < 3; ++ib) {
                u32x4 raw[4][4];
#pragma unroll
                for (int u = 0; u < 4; ++u) {
                    const int idx = t + 256 * (4 * ib + u), pp = idx / 48, oct = idx - pp * 48, cq = (oct >> 4) * 1024 + h * 128 + (oct & 15) * 8;
                    const int tk = tok0 + pp;
#pragma unroll
                    for (int j = 0; j < 4; ++j) { int tj = tk - j; tj = tj < 0 ? 0 : (tj >= Tseq ? Tseq - 1 : tj);
                        raw[u][j] = *(const u32x4*)(PROJ + (size_t)(rowbase + tj) * 6144 + 3072 + cq);
}
                }
#pragma unroll
                for (int u = 0; u < 4; ++u) {
                    const int idx = t + 256 * (4 * ib + u), pp = idx / 48, oct = idx - pp * 48, which = oct >> 4, d0 = (oct & 15) * 8, cq = which * 1024 + h * 128 + d0;
                    const int tk = tok0 + pp; const bool valid = (tk >= 0 && tk < Tseq);
                    float y[8];
#pragma unroll
                    for (int e = 0; e < 8; ++e) y[e] = 0.f;
#pragma unroll
                    for (int j = 0; j < 4; ++j) { const float m = (tk - j >= 0) ? 1.f : 0.f; const u32x4 r = raw[u][j]; const LAS float* wlp = Mm + (3 - j) * 384 + which * 128 + d0; const f32x4 wa = *(const LAS f32x4*)wlp * m, wb = *(const LAS f32x4*)(wlp + 4) * m;
                        y[0] += wa[0] * bflo(r.x); y[1] += wa[1] * bfhi(r.x); y[2] += wa[2] * bflo(r.y); y[3] += wa[3] * bfhi(r.y); y[4] += wb[0] * bflo(r.z); y[5] += wb[1] * bfhi(r.z); y[6] += wb[2] * bflo(r.w); y[7] += wb[3] * bfhi(r.w); }
                    if (samp && valid && tk < 3) {
#pragma unroll
                        for (int j = 1; j < 4; ++j) if (tk - j < 0) { const float* hp = p.st_gdn_conv + ((size_t)sidx * 3 + (3 + tk - j)) * 3072 + cq; const f32x4 a = *(const f32x4*)hp, bq = *(const f32x4*)(hp + 4);
                            const LAS float* wlp = Mm + (3 - j) * 384 + which * 128 + d0; const f32x4 wa = *(const LAS f32x4*)wlp, wb = *(const LAS f32x4*)(wlp + 4);
                            y[0] += wa[0] * a[0]; y[1] += wa[1] * a[1]; y[2] += wa[2] * a[2]; y[3] += wa[3] * a[3];
                            y[4] += wb[0] * bq[0]; y[5] += wb[1] * bq[1]; y[6] += wb[2] * bq[2]; y[7] += wb[3] * bq[3]; }
                    }
                    float ss = 0.f;
#pragma unroll
                    for (int e = 0; e < 8; ++e) { y[e] = valid ? silu_f(y[e]) : 0.f; ss += y[e] * y[e]; }
                    ss += __shfl_xor(ss, 1); ss += __shfl_xor(ss, 2); ss += __shfl_xor(ss, 4); ss += __shfl_xor(ss, 8);
                    float sc = 1.f;
                    if (which == 0) sc = rsqrtf(ss + EPS) * 0.08838834764831845f; else if (which == 1) sc = rsqrtf(ss + EPS);
                    u32x4 o; o.x = cvt_pk_bf16(y[0] * sc, y[1] * sc); o.y = cvt_pk_bf16(y[2] * sc, y[3] * sc); o.z = cvt_pk_bf16(y[4] * sc, y[5] * sc); o.w = cvt_pk_bf16(y[6] * sc, y[7] * sc);
                    LAS bf16_t* dst = (which == 0 ? Qb : (which == 1 ? Kb : Vb)) + pp * 136 + d0;
                    *(LAS u32x4*)dst = o;
                }
            }
            __syncthreads();
            P2(1) {
                const int ti = hw, i = 16 * ti + fr; const float gi = gc[i], bi = bt[i];
                bf16x8 ka[4], qa[4];
#pragma unroll
                for (int kb = 0; kb < 4; ++kb) { ka[kb] = *(const LAS bf16x8*)(Kb + i * 136 + kb * 32 + fq * 8); qa[kb] = *(const LAS bf16x8*)(Qb + i * 136 + kb * 32 + fq * 8); }
#pragma unroll 1
                for (int tj = 0; tj <= (ti | 1); ++tj) {
                    f32x4 kk = (f32x4){0.f, 0.f, 0.f, 0.f}, qk = kk;
                    if (tj <= ti) {
#pragma unroll
                        for (int kb = 0; kb < 4; ++kb) { const bf16x8 b = *(const LAS bf16x8*)(Kb + (16 * tj + fr) * 136 + kb * 32 + fq * 8);
                            kk = __builtin_amdgcn_mfma_f32_16x16x32_bf16(b, ka[kb], kk, 0, 0, 0); qk = __builtin_amdgcn_mfma_f32_16x16x32_bf16(b, qa[kb], qk, 0, 0, 0); }
                    }
                    const int jb = 16 * tj + 4 * fq; const f32x4 gj = *(const LAS f32x4*)(gc + jb);
                    f32x4 mrow, arow;
#pragma unroll
                    for (int jj = 0; jj < 4; ++jj) { const int j = jb + jj; const float dec = (i >= j) ? __expf(gi - gj[jj]) : 0.f; mrow[jj] = (i > j) ? bi * kk[jj] * dec : 0.f; arow[jj] = qk[jj] * dec; }
                    if (tj <= ti) *(LAS f32x4*)(Mm + i * 64 + jb) = mrow;
                    u32x2 aw; aw.x = cvt_pk_bf16(arow[0], arow[1]); aw.y = cvt_pk_bf16(arow[2], arow[3]);
                    *(u32x2*)(ATTg + i * 64 + (tj >> 1) * 32 + 8 * fq + 4 * (tj & 1)) = aw;
                }
            }
            P2(2) {
#pragma unroll
                for (int i = 0; i < 4; ++i) { const int v = t + 256 * i, tok = v >> 4, oct = v & 15, dkb = (oct >> 2) * 32 + (oct & 3) * 4; const float e = eg[tok];
                    const u32x2 lo = *(const LAS u32x2*)(Qb + tok * 136 + dkb), hi = *(const LAS u32x2*)(Qb + tok * 136 + dkb + 16);
                    u32x4 o; o.x = cvt_pk_bf16(bflo(lo.x) * e, bfhi(lo.x) * e); o.y = cvt_pk_bf16(bflo(lo.y) * e, bfhi(lo.y) * e); o.z = cvt_pk_bf16(bflo(hi.x) * e, bfhi(hi.x) * e); o.w = cvt_pk_bf16(bflo(hi.y) * e, bfhi(hi.y) * e);
                    *(u32x4*)(QGg + tok * 128 + 8 * oct) = o; }
#pragma unroll
                for (int i = 0; i < 4; ++i) { const int v = t + 256 * i, dk = v >> 3, oct = v & 7, tb = (oct >> 2) * 32 + (oct & 3) * 4; float f[8];
#pragma unroll
                    for (int e = 0; e < 8; ++e) { const int tok = tb + (e >> 2) * 16 + (e & 3); f[e] = bf2f(Kb[tok * 136 + dk]) * kdv[tok]; }
                    u32x4 o; o.x = cvt_pk_bf16(f[0], f[1]); o.y = cvt_pk_bf16(f[2], f[3]); o.z = cvt_pk_bf16(f[4], f[5]); o.w = cvt_pk_bf16(f[6], f[7]);
                    *(u32x4*)(KDTg + dk * 64 + 8 * oct) = o; }
                if (t == 0) { const float e63 = eg[63]; EGL[item] = e63; *(f32x4*)(blob + 73728) = (f32x4){e63, e63, e63, e63}; }
            }
            __syncthreads();
            P2(3) {
                float x[64];
                const bool isU = t < 128; const int c = t & 127; const LAS bf16_t* src = isU ? Vb : Kb;
                SubstAll<63>::run(x, Mm, src + c, isU ? bt : bw);
                if (isU) {
#pragma unroll
                    for (int q = 0; q < 8; ++q) { u32x4 o; o.x = cvt_pk_bf16(x[8 * q], x[8 * q + 1]); o.y = cvt_pk_bf16(x[8 * q + 2], x[8 * q + 3]); o.z = cvt_pk_bf16(x[8 * q + 4], x[8 * q + 5]); o.w = cvt_pk_bf16(x[8 * q + 6], x[8 * q + 7]);
                        *(u32x4*)(UTg + c * 64 + 8 * q) = o; }
                } else { const int pc = (c & 96) + perm32(c & 31);
#pragma unroll
                    for (int i = 0; i < 64; ++i) Qb[i * 136 + pc] = f2bf(x[i]); }
            }
            __syncthreads();
#pragma unroll
            for (int i = 0; i < 4; ++i) { const int v = t + 256 * i, row = v >> 4, oct = v & 15; *(u32x4*)(Wg + row * 128 + 8 * oct) = *(const LAS u32x4*)(Qb + row * 136 + 8 * oct); }
            __syncthreads();
        }
        P2(4) if (bx >= 48) for (int grp = (bx - 48) * 8 + wave; grp < ROWS_V / 8; grp += (G - 48) * 8) {
            const int R0 = grp * 8; int sq, t0, Tseq; bool samp;
            if (R0 < ROWS_P) { sq = R0 / NPT; t0 = R0 - sq * NPT; Tseq = NPT; samp = false; } else { sq = (R0 - ROWS_P) >> 4; t0 = (R0 - ROWS_P) & 15; Tseq = 16; samp = true; }
            const int c0 = lane * 16;
            float cm1[16], cm2[16], wa0[16], wa1[16], wa2[16], gna[16];
#pragma unroll
            for (int q = 0; q < 4; ++q) { const f32x4 a0 = *(const f32x4*)(p.w_conv_a + c0 + 4 * q), a1 = *(const f32x4*)(p.w_conv_a + 1024 + c0 + 4 * q), a2 = *(const f32x4*)(p.w_conv_a + 2048 + c0 + 4 * q), gg = *(const f32x4*)(p.g_norm_a + c0 + 4 * q);
#pragma unroll
                for (int e = 0; e < 4; ++e) { wa0[4 * q + e] = a0[e]; wa1[4 * q + e] = a1[e]; wa2[4 * q + e] = a2[e]; gna[4 * q + e] = gg[e]; } }
            if (t0 == 0) {
#pragma unroll
                for (int e = 0; e < 16; ++e) { cm2[e] = samp ? p.st_conv_a[((size_t)sq * 2 + 0) * 1024 + c0 + e] : 0.f; cm1[e] = samp ? p.st_conv_a[((size_t)sq * 2 + 1) * 1024 + c0 + e] : 0.f; }
            } else {
#pragma unroll
                for (int k = 0; k < 2; ++k) { const bf16_t* rp = PROJ + (size_t)(R0 - 2 + k) * 6144 + c0;
#pragma unroll
                    for (int q = 0; q < 2; ++q) { const u32x4 ah = *(const u32x4*)(rp + 8 * q), ac = *(const u32x4*)(rp + 1024 + 8 * q); float d[8];
                        d[0] = bflo(ah.x) * bflo(ac.x); d[1] = bfhi(ah.x) * bfhi(ac.x); d[2] = bflo(ah.y) * bflo(ac.y); d[3] = bfhi(ah.y) * bfhi(ac.y);
                        d[4] = bflo(ah.z) * bflo(ac.z); d[5] = bfhi(ah.z) * bfhi(ac.z); d[6] = bflo(ah.w) * bflo(ac.w); d[7] = bfhi(ah.w) * bfhi(ac.w);
#pragma unroll
                        for (int e = 0; e < 8; ++e) { if (k == 0) cm2[8 * q + e] = d[e]; else cm1[8 * q + e] = d[e]; } } }
            }
            u32x4 nx[6];
            { const bf16_t* rp = PROJ + (size_t)R0 * 6144 + c0;
#pragma unroll
              for (int q = 0; q < 2; ++q) { nx[3 * q] = *(const u32x4*)(rp + 8 * q); nx[3 * q + 1] = *(const u32x4*)(rp + 1024 + 8 * q); nx[3 * q + 2] = *(const u32x4*)(rp + 2048 + 8 * q); } }
#pragma unroll 1
            for (int r = 0; r < 8; ++r) {
                const int R = R0 + r, tt = t0 + r;
                u32x4 cu[6];
#pragma unroll
                for (int q = 0; q < 6; ++q) cu[q] = nx[q];
                if (r < 7) { const bf16_t* rp = PROJ + (size_t)(R + 1) * 6144 + c0;
#pragma unroll
                    for (int q = 0; q < 2; ++q) { nx[3 * q] = *(const u32x4*)(rp + 8 * q); nx[3 * q + 1] = *(const u32x4*)(rp + 1024 + 8 * q); nx[3 * q + 2] = *(const u32x4*)(rp + 2048 + 8 * q); } }
                float ca[16], v[16]; float ss = 0.f;
#pragma unroll
                for (int q = 0; q < 2; ++q) { const u32x4 ah = cu[3 * q], ac = cu[3 * q + 1], ab = cu[3 * q + 2]; float* d = ca + 8 * q; float bb[8];
                    d[0] = bflo(ah.x) * bflo(ac.x); d[1] = bfhi(ah.x) * bfhi(ac.x); d[2] = bflo(ah.y) * bflo(ac.y); d[3] = bfhi(ah.y) * bfhi(ac.y);
                    d[4] = bflo(ah.z) * bflo(ac.z); d[5] = bfhi(ah.z) * bfhi(ac.z); d[6] = bflo(ah.w) * bflo(ac.w); d[7] = bfhi(ah.w) * bfhi(ac.w);
                    bb[0] = bflo(ab.x); bb[1] = bfhi(ab.x); bb[2] = bflo(ab.y); bb[3] = bfhi(ab.y); bb[4] = bflo(ab.z); bb[5] = bfhi(ab.z); bb[6] = bflo(ab.w); bb[7] = bfhi(ab.w);
#pragma unroll
                    for (int e = 0; e < 8; ++e) { const float yv = wa2[8 * q + e] * d[e] + wa1[8 * q + e] * cm1[8 * q + e] + wa0[8 * q + e] * cm2[8 * q + e];
                        v[8 * q + e] = bb[e] * yv; ss += v[8 * q + e] * v[8 * q + e]; } }
                const float rn = rsqrtf(wave_sum(ss) * (1.f / 1024.f) + EPS);
                bf16_t* mrow = Bm + (size_t)mu_row(R) * DM + c0;
#pragma unroll
                for (int q = 0; q < 2; ++q) { float o[8];
#pragma unroll
                    for (int e = 0; e < 8; ++e) o[e] = v[8 * q + e] * rn * gna[8 * q + e];
                    u32x4 w; w.x = cvt_pk_bf16(o[0], o[1]); w.y = cvt_pk_bf16(o[2], o[3]); w.z = cvt_pk_bf16(o[4], o[5]); w.w = cvt_pk_bf16(o[6], o[7]);
                    *(u32x4*)(mrow + 8 * q) = w; }
                if (tt >= Tseq - 2) { float* d = out + (samp ? O_NCA_S : O_NCA_P) + ((size_t)sq * 2 + (tt - (Tseq - 2))) * 1024 + c0;
#pragma unroll
                    for (int e = 0; e < 16; ++e) d[e] = ca[e]; }
#pragma unroll
                for (int e = 0; e < 16; ++e) { cm2[e] = cm1[e]; cm1[e] = ca[e]; }
            }
        }
        for (int idx = gtid; idx < 12 * 3 * 3072; idx += NGT) {
            const int col = idx % 3072, r = (idx / 3072) % 3, sq = idx / 9216;
            if (sq < 4) out[O_NGC_P + ((size_t)sq * 3 + r) * 3072 + col] = bf2f(PROJ[(size_t)(sq * NPT + NPT - 3 + r) * 6144 + 3072 + col]);
            else out[O_NGC_S + ((size_t)(sq - 4) * 3 + r) * 3072 + col] = bf2f(PROJ[(size_t)(ROWS_P + (sq - 4) * 16 + 13 + r) * 6144 + 3072 + col]);
        }
    }
    xcd_barrier(xbar);

    PH(3) {
        PHASE_LOCALS
        const int fr = lane & 15, fq = lane >> 4;
        constexpr int RB = 59408;
        if (bx < 256) {
            const int x = bx & 7, y = bx >> 3, bh = x * 4 + (y >> 3), sl = y & 7, sidx = bh >> 3, h = bh & 7, item0 = bh * 65, dv0 = 16 * sl, rowbase = sidx * NPT;
            f32x4 S[8];
#pragma unroll
            for (int dt = 0; dt < 8; ++dt) S[dt] = (f32x4){0.f, 0.f, 0.f, 0.f};
            u32x4 stg0[12], stg1[12], stg2[12];
            const int lt = tid - 64;
#define P3_ISSUE(stg, eg, c) do { const unsigned char* bsrc = GDN + (size_t)(item0 + (c)) * BLOB; _Pragma("unroll") for (int k = 0; k < 12; ++k) { int i = lt + 320 * k; i = i > 3712 ? 3712 : i; \
                const int so = i < 3584 ? i * 16 : (i < 3712 ? 57344 + dv0 * 128 + (i - 3584) * 16 : 73728); stg[k] = *(const u32x4*)(bsrc + so); } } while (0)
#define P3_WRITE(stg, eg, c) do { LAS unsigned char* bdst = lds + ((c) & 1) * RB; _Pragma("unroll") for (int k = 0; k < 12; ++k) { int i = lt + 320 * k; i = i > 3712 ? 3712 : i; *(LAS u32x4*)(bdst + i * 16) = stg[k]; } } while (0)
#define P3_BAR() do { asm volatile("s_waitcnt lgkmcnt(0)" ::: "memory"); __builtin_amdgcn_s_barrier(); asm volatile("" ::: "memory"); } while (0)
#define P3_COMPUTE(c) do { const LAS bf16_t* Wl = (const LAS bf16_t*)(lds + ((c) & 1) * RB); \
                gdn_step_lds(S, Wl, Wl + 28672, *(const LAS float*)(Wl + 29696), OBUF + (size_t)rowbase * 1024 + h * 128 + dv0 + fr, 64 * (c) - 48, NPT, fr, fq); } while (0)
            if (wave == 0) {
                P3_BAR();
#pragma unroll 1
                for (int c = 0; c < 65; ++c) { P3_COMPUTE(c); P3_BAR(); }
            } else if (wave < 6) {
                P3_ISSUE(stg0, 0, 0); P3_ISSUE(stg1, 0, 1); P3_ISSUE(stg2, 0, 2); P3_WRITE(stg0, 0, 0);
                P3_BAR();
#pragma unroll 1
                for (int c = 0; c < 63; c += 3) {
                    if (c + 3 < 65) P3_ISSUE(stg0, 0, c + 3); P3_WRITE(stg1, 0, c + 1);
                    P3_BAR();
                    if (c + 4 < 65) P3_ISSUE(stg1, 0, c + 4); P3_WRITE(stg2, 0, c + 2);
                    P3_BAR();
                    if (c + 5 < 65) P3_ISSUE(stg2, 0, c + 5); P3_WRITE(stg0, 0, c + 3);
                    P3_BAR();
                }
                P3_WRITE(stg1, 0, 64);
                P3_BAR();
                P3_BAR();
            } else {
                constexpr int I_UP = 32 * 352, I_DN = 88 * 64;
                LAS float* scr = (LAS float*)(lds + 2 * RB + (wave - 6) * 8448);
                const int sw = bx * 2 + (wave - 6);
                float tr[32];
#define P3_TR_ISSUE(it) do { if ((it) < I_UP) { const int kb = (it) / 352, nb = (it) - kb * 352; transpose_issue(tr, p.w_up, 2 * DFF, 64 * kb, 32 * nb, lane); } \
                    else { const int r_ = (it) - I_UP, kb = r_ >> 6, nb = r_ & 63; transpose_issue(tr, p.w_down, DM, 64 * kb, 32 * nb, lane); } } while (0)
#define P3_TR_FINISH(it) do { if ((it) < I_UP) { const int kb = (it) / 352, nb = (it) - kb * 352, n0 = 32 * nb; const int j_ = n0 < DFF ? n0 : n0 - DFF; const int drow = 256 * (j_ >> 7) + (n0 < DFF ? 0 : 128) + (j_ & 127); \
                        transpose_finish(tr, Wt_up, DM, 64 * kb, drow, scr, lane); } \
                    else { const int r_ = (it) - I_UP, kb = r_ >> 6, nb = r_ & 63; transpose_finish(tr, Wt_down, DFF, 64 * kb, 32 * nb, scr, lane); } } while (0)
                int it = sw;
                if (it < I_UP + I_DN) P3_TR_ISSUE(it);
                P3_BAR();
#pragma unroll 1
                for (int c = 0; c < 65; ++c) {
                    if (it < I_UP + I_DN) { P3_TR_FINISH(it); it += 512; if (it < I_UP + I_DN) P3_TR_ISSUE(it); }
                    P3_BAR();
                }
#pragma unroll 1
                while (it < I_UP + I_DN) { P3_TR_FINISH(it); it += 512; if (it < I_UP + I_DN) P3_TR_ISSUE(it); }
            }
            if (wave == 0) {
                float* sd = out + O_NGD_P + ((size_t)sidx * 8 + h) * 16384;
#pragma unroll
                for (int dt = 0; dt < 8; ++dt)
#pragma unroll
                    for (int jj = 0; jj < 4; ++jj) sd[(16 * dt + 4 * fq + jj) * 128 + dv0 + fr] = S[dt][jj];
            }
        }
        if (wave < 2) {
            const int w = 2 * bx + wave;
            if (w < 512) {
                const int sh = w >> 3, sl = w & 7, sidx = sh >> 3, h = sh & 7, dv0 = 16 * sl, item = NITEM_P + sh;
                f32x4 S[8];
#pragma unroll
                for (int dt = 0; dt < 8; ++dt)
#pragma unroll
                    for (int jj = 0; jj < 4; ++jj) S[dt][jj] = p.st_gdn[(((size_t)sidx * 8 + h) * 128 + 16 * dt + 4 * fq + jj) * 128 + dv0 + fr];
                const bf16_t* Wg = (const bf16_t*)(GDN + (size_t)item * BLOB);
                gdn_step_glb(S, Wg, Wg + 28672 + dv0 * 64, EGL[item], OBUF + (size_t)(ROWS_P + sidx * 16) * 1024 + h * 128 + dv0 + fr, 0, 16, fr, fq);
                float* sd = out + O_NGD_S + ((size_t)sidx * 8 + h) * 16384;
#pragma unroll
                for (int dt = 0; dt < 8; ++dt)
#pragma unroll
                    for (int jj = 0; jj < 4; ++jj) sd[(16 * dt + 4 * fq + jj) * 128 + dv0 + fr] = S[dt][jj];
            }
        }
    }
    xcd_barrier(xbar);

    PH(4) {
        PHASE_LOCALS
        for (int R = gw; R < ROWS_V; R += NGW) {
            const int hh = lane >> 3, e0 = (lane & 7) * 16; const float* op = OBUF + (size_t)R * 1024 + hh * 128 + e0;
            f32x4 o[4]; float ss = 0.f;
#pragma unroll
            for (int q = 0; q < 4; ++q) { o[q] = *(const f32x4*)(op + 4 * q); ss += (o[q][0] * o[q][0] + o[q][1] * o[q][1]) + (o[q][2] * o[q][2] + o[q][3] * o[q][3]); }
            ss += __shfl_xor(ss, 1); ss += __shfl_xor(ss, 2); ss += __shfl_xor(ss, 4);
            const float rn = rsqrtf(ss * (1.f / 128.f) + EPS);
            const bf16_t* zp = Zb + (size_t)R * 1024 + hh * 128 + e0;
#pragma unroll
            for (int q = 0; q < 2; ++q) { const u32x4 zr = *(const u32x4*)(zp + 8 * q); float zz[8] = {bflo(zr.x), bfhi(zr.x), bflo(zr.y), bfhi(zr.y), bflo(zr.z), bfhi(zr.z), bflo(zr.w), bfhi(zr.w)}; float y[8];
#pragma unroll
                for (int e = 0; e < 8; ++e) y[e] = o[2 * q + (e >> 2)][e & 3] * rn * p.g_norm_gdn[e0 + 8 * q + e] * silu_f(zz[e]);
                u32x4 w; w.x = cvt_pk_bf16(y[0], y[1]); w.y = cvt_pk_bf16(y[2], y[3]); w.z = cvt_pk_bf16(y[4], y[5]); w.w = cvt_pk_bf16(y[6], y[7]);
                *(u32x4*)(Bm + (size_t)mu_row(R) * DM + 1024 + hh * 128 + e0 + 8 * q) = w; }
        }
    }
    xcd_barrier(xbar);

    PH(5) {
        PHASE_LOCALS
        pg8::Gemm g{Bm, Wt_out, DM, (size_t)256 * DM * 2}; pg8::StaticOrder S; S.init(64, 8, G, bx);
        pg8::EpiBf16Part E{MOb, PART};
        pg8::gemm_phase<pg8::EpiBf16Part>(lds, g, S, E);
        const int fr = lane & 15, fq = lane >> 4;
        for (int job = bx; job < 12 * 32; job += G) {
            const int rt = job % 12, cgp = job / 12;
            const bf16_t* ap = Bm + (size_t)(16384 + 16 * rt + fr) * DM + 8 * fq + wave * 256;
            const bf16_t* bp = Wt_out + (size_t)(64 * cgp + fr) * DM + 8 * fq + wave * 256;
            f32x4 acc[4];
#pragma unroll
            for (int n = 0; n < 4; ++n) acc[n] = (f32x4){0.f, 0.f, 0.f, 0.f};
#pragma unroll 2
            for (int ks = 0; ks < 8; ++ks) { const bf16x8 a = *(const bf16x8*)(ap + 32 * ks);
#pragma unroll
                for (int n = 0; n < 4; ++n) { const bf16x8 b = *(const bf16x8*)(bp + (size_t)16 * n * DM + 32 * ks); acc[n] = __builtin_amdgcn_mfma_f32_16x16x32_bf16(b, a, acc[n], 0, 0, 0); } }
            LAS f32x4* red = (LAS f32x4*)lds;
            __syncthreads();
#pragma unroll
            for (int n = 0; n < 4; ++n) red[(wave * 4 + n) * 64 + lane] = acc[n];
            __syncthreads();
            if (wave == 0) {
                float ss = 0.f; const int q = 16384 + 16 * rt + fr;
#pragma unroll
                for (int n = 0; n < 4; ++n) { f32x4 v = red[n * 64 + lane];
#pragma unroll
                    for (int w2 = 1; w2 < 8; ++w2) v += red[(w2 * 4 + n) * 64 + lane];
                    ss += (v[0] * v[0] + v[1] * v[1]) + (v[2] * v[2] + v[3] * v[3]);
                    u32x2 w; w.x = cvt_pk_bf16(v[0], v[1]); w.y = cvt_pk_bf16(v[2], v[3]); *(u32x2*)(MOb + (size_t)q * DM + 64 * cgp + 16 * n + 4 * fq) = w; }
                ss += __shfl_xor(ss, 16); ss += __shfl_xor(ss, 32);
                if (fq == 0) PART[(size_t)q * 32 + cgp] = ss;
            }
        }
    }
    xcd_barrier(xbar);

    PH(6) {
        PHASE_LOCALS
        {
            f32x4 nx[8]; u32x2 nm[8]; float nps = 0.f;
            const float* xr = x_row(p, gw - 2);
            if (xr) { const int mr = mu_row(gw - 2); nps = (lane < 32) ? PART[(size_t)mr * 32 + lane] : 0.f;
#pragma unroll
                for (int j = 0; j < 8; ++j) { const int c = 4 * lane + 256 * j; nx[j] = __builtin_nontemporal_load((const f32x4*)(xr + c)); nm[j] = *(const u32x2*)(MOb + (size_t)mr * DM + c); } }
#pragma unroll 1
            for (int R = gw - 2; R < 16768; R += NGW) {
                const bool live = xr != nullptr; f32x4 xv[8]; u32x2 mv2[8]; float ps = nps;
#pragma unroll
                for (int j = 0; j < 8; ++j) { xv[j] = nx[j]; mv2[j] = nm[j]; }
                const int Rn = R + NGW; xr = (Rn < 16768) ? x_row(p, Rn) : nullptr;
                if (xr) { const int mr = mu_row(Rn); nps = (lane < 32) ? PART[(size_t)mr * 32 + lane] : 0.f;
#pragma unroll
                    for (int j = 0; j < 8; ++j) { const int c = 4 * lane + 256 * j; nx[j] = __builtin_nontemporal_load((const f32x4*)(xr + c)); nm[j] = *(const u32x2*)(MOb + (size_t)mr * DM + c); } }
                bf16_t* orow = Bm + (size_t)R * DM;
                if (live) {
                    ps = wave_sum(ps);
                    const float rn = rsqrtf(ps * (1.f / DM) + EPS);
                    f32x4 v[8];
#pragma unroll
                    for (int j = 0; j < 8; ++j) { const int c = 4 * lane + 256 * j; const f32x4 gg = *(const f32x4*)(p.g_post_mix + c); const f32x4 mv = (f32x4){bflo(mv2[j].x), bfhi(mv2[j].x), bflo(mv2[j].y), bfhi(mv2[j].y)};
                        v[j] = xv[j] + mv * rn * gg; u32x2 xw; xw.x = cvt_pk_bf16(v[j][0], v[j][1]); xw.y = cvt_pk_bf16(v[j][2], v[j][3]); *(u32x2*)(X1 + (size_t)R * DM + c) = xw; }
                    norm_store_bf16(v, p.g_pre_ffn, orow, lane);
                } else {
#pragma unroll
                    for (int j = 0; j < 8; ++j) *(u32x2*)(orow + 4 * lane + 256 * j) = (u32x2){0u, 0u};
                }
            }
        }
    }
    xcd_barrier(xbar);

    PH(7) {
        PHASE_LOCALS
        pg8::Gemm g{Bm - 2 * DM, Wt_up, DM, (size_t)254 * DM * 2}; pg8::StaticOrder S; S.init(66, 44, G, bx);
        pg8::EpiGate E{Fb, p.w_conv_ffn, p.st_ffn_conv, out, (LAS float*)(lds + pg8::STAGE_BYTES)};
        pg8::gemm_phase<pg8::EpiGate>(lds, g, S, E);
    }
    xcd_barrier(xbar);

    PH(9) {
        PHASE_LOCALS
        pg8::Gemm g{Fb, Wt_down, DFF, (size_t)256 * DFF * 2}; pg8::PanelOrder S{bx};
        pg8::EpiFinal E{out + O_YP, X1, p.g_post_ffn, (float*)(ws + 512 * 1024), (unsigned*)ws + 8192, (LAS float*)(lds + pg8::STAGE_BYTES)};
        if (G == 256) pg8::gemm_phase<pg8::EpiFinal, pg8::PanelOrder>(lds, g, S, E);
        if (bx < 256) {
            const int fr = lane & 15, fq = lane >> 4, rt = bx & 7, cgp = bx >> 3;
            const bf16_t* ap = Fb + (size_t)(16384 + 16 * rt + fr) * DFF + 8 * fq + wave * 704;
            const bf16_t* bp = Wt_down + (size_t)(64 * cgp + fr) * DFF + 8 * fq + wave * 704;
            f32x4 acc[4];
#pragma unroll
            for (int n = 0; n < 4; ++n) acc[n] = (f32x4){0.f, 0.f, 0.f, 0.f};
#pragma unroll 2
            for (int ks = 0; ks < 22; ++ks) { const bf16x8 a = *(const bf16x8*)(ap + 32 * ks);
#pragma unroll
                for (int n = 0; n < 4; ++n) { const bf16x8 b = *(const bf16x8*)(bp + (size_t)16 * n * DFF + 32 * ks); acc[n] = __builtin_amdgcn_mfma_f32_16x16x32_bf16(b, a, acc[n], 0, 0, 0); } }
            LAS f32x4* red = (LAS f32x4*)lds;
#pragma unroll
            for (int n = 0; n < 4; ++n) red[(wave * 4 + n) * 64 + lane] = acc[n];
            __syncthreads();
            if (wave == 0) {
                float ss = 0.f; const int q = 16384 + 16 * rt + fr;
#pragma unroll
                for (int n = 0; n < 4; ++n) { f32x4 v = red[n * 64 + lane];
#pragma unroll
                    for (int w2 = 1; w2 < 8; ++w2) v += red[(w2 * 4 + n) * 64 + lane];
                    ss += (v[0] * v[0] + v[1] * v[1]) + (v[2] * v[2] + v[3] * v[3]);
                    u32x2 w; w.x = cvt_pk_bf16(v[0], v[1]); w.y = cvt_pk_bf16(v[2], v[3]); *(u32x2*)(FOb + (size_t)q * DM + 64 * cgp + 16 * n + 4 * fq) = w; }
                ss += __shfl_xor(ss, 16); ss += __shfl_xor(ss, 32);
                if (fq == 0) PART[(size_t)q * 32 + cgp] = ss;
            }
        }
    }
    xcd_barrier(xbar);

    PH(10) {
        PHASE_LOCALS
        for (int q = 16384 + gw; q < 16384 + 128; q += NGW) {
            int R; float* yrow;
            if (q < 16384) { const int b = q >> 12, t = q & 4095; R = b * NPT + 16 + t; yrow = out + O_YP + (size_t)q * DM; } else { R = ROWS_P + (q - 16384); yrow = out + O_YS + (size_t)(q - 16384) * DM; }
            float ps = (lane < 32) ? PART[(size_t)q * 32 + lane] : 0.f; ps = wave_sum(ps);
            const float rn = rsqrtf(ps * (1.f / DM) + EPS);
#pragma unroll
            for (int j = 0; j < 8; ++j) { const int c = 4 * lane + 256 * j; const f32x4 gg = *(const f32x4*)(p.g_post_ffn + c); const u32x2 fr2 = *(const u32x2*)(FOb + (size_t)q * DM + c); const f32x4 fv = (f32x4){bflo(fr2.x), bfhi(fr2.x), bflo(fr2.y), bfhi(fr2.y)}; const u32x2 xr2 = *(const u32x2*)(X1 + (size_t)R * DM + c); const f32x4 xv = (f32x4){bflo(xr2.x), bfhi(xr2.x), bflo(xr2.y), bfhi(xr2.y)};
                *(f32x4*)(yrow + c) = xv + fv * rn * gg; }
        }
    }
}

extern "C" void kernel_launch(void* const* d_in, const int* in_sizes, int n_in, void* d_out, int out_size, void* d_ws, size_t ws_size, hipStream_t stream) {
    static int grid = 0;
    if (grid == 0) {
        if (n_in != 22 || (size_t)out_size != O_END || ws_size < WS_END) { fprintf(stderr, "kernel_launch: unexpected shapes: n_in %d out %d ws %zu\n", n_in, out_size, ws_size); grid = -1; return; }
        int dev = 0, cus = 0, per_cu = 0;
        hipGetDevice(&dev); hipDeviceGetAttribute(&cus, hipDeviceAttributeMultiprocessorCount, dev);
        hipFuncSetAttribute((const void*)hymba_fwd, hipFuncAttributeMaxDynamicSharedMemorySize, LDS_BYTES);
        hipOccupancyMaxActiveBlocksPerMultiprocessor(&per_cu, (const void*)hymba_fwd, 512, LDS_BYTES);
        if (per_cu < 1) { fprintf(stderr, "kernel_launch: occupancy query says %d blocks per CU\n", per_cu); per_cu = 1; }
        grid = cus;
        (void)hipGetLastError();
    }
    if (grid < 0) return;
    (void)hipMemsetAsync(d_ws, 0, 65536, stream);
    Params p{};
    const float** pp = (const float**)&p;
    for (int i = 0; i < 22; ++i) pp[i] = (const float*)d_in[i];
    p.out = (float*)d_out; p.ws = (unsigned char*)d_ws;
    void* args[] = {&p};
    hipError_t e = hipLaunchCooperativeKernel((const void*)hymba_fwd, dim3(grid), dim3(512), args, LDS_BYTES, stream);
    if (e != hipSuccess) fprintf(stderr, "cooperative launch failed: %s (grid %d)\n", hipGetErrorString(e), grid);
}
```
